# Optimizing an MI355X kernel written in HIP

```python
import math
import jax, jax.numpy as jnp
from jax import lax
import numpy as np

D_MODEL = 1024
BATCH = 8
SEQ = 4096
DEPTH = 2

MEM_LEN = 256
HEAD_DIM = 64
ROPE_THETA = 10000.0
BLOCK_Q = 128
EPS = 1e-5
A_HEADS = 4
A_QK = A_HEADS * 2 * HEAD_DIM
A_V = A_HEADS * 2 * HEAD_DIM
A_OUT = A_V
B_HEADS = 8
B_W = B_HEADS * HEAD_DIM
B_OUT = B_W
FORGET_BIAS_LO = 1.0
FORGET_BIAS_HI = 5.0
C_PATTERNS = ((128, 1), (512, 4), (2048, 16))
C_GROUPS = len(C_PATTERNS)
C_SLOTS = 4
C_W = C_GROUPS * C_SLOTS * HEAD_DIM
C_OUT = C_SLOTS * HEAD_DIM
N_BRANCH = 3
IN_SIZES = (A_QK, A_QK, A_V, B_W, B_W, B_W, B_HEADS, C_W, C_W, C_W)
IN_COLS = sum(IN_SIZES)
IN_SPLITS = np.cumsum(IN_SIZES)[:-1].tolist()
X_HEADS = 4
X_HEAD_DIM = D_MODEL // X_HEADS
N_GROUPS = 4
EXPERTS_PER_GROUP = 4
EXPERT_TOPK = 2
D_EXPERT = D_MODEL // 4
DN_ALPHA = (2 * DEPTH) ** 0.25
DN_BETA = (8 * DEPTH) ** -0.25
N_SUBLAYERS = 3

kernel_name = "hybrid_diff_fox_dilated_hmoe_deepnorm"


def layer_norm(x, g, b):
    xf = x.astype(jnp.float32)
    mu = jnp.mean(xf, axis=-1, keepdims=True)
    var = jnp.mean(jnp.square(xf - mu), axis=-1, keepdims=True)
    return ((xf - mu) * lax.rsqrt(var + EPS) * g + b).astype(x.dtype)


def rms_norm(x, g):
    xf = x.astype(jnp.float32)
    return (xf * lax.rsqrt(jnp.mean(jnp.square(xf), axis=-1, keepdims=True) + EPS) * g).astype(x.dtype)


def rope(x, positions):
    half = x.shape[-1] // 2
    inv = ROPE_THETA ** (-jnp.arange(half, dtype=jnp.float32) / half)
    ang = positions.astype(jnp.float32)[:, :, None, None] * inv
    cos, sin = jnp.cos(ang), jnp.sin(ang)
    xf = x.astype(jnp.float32)
    x1, x2 = xf[..., :half], xf[..., half:]
    return jnp.concatenate([x1 * cos - x2 * sin, x2 * cos + x1 * sin], axis=-1).astype(x.dtype)


def _to_blocks(t):
    b, s = t.shape[:2]
    return jnp.moveaxis(t.reshape((b, s // BLOCK_Q, BLOCK_Q) + t.shape[2:]), 1, 0)


def _from_blocks(t):
    n, b, q = t.shape[:3]
    return jnp.moveaxis(t, 0, 1).reshape((b, n * q) + t.shape[3:])


def diff_attention(q1, q2, k1, k2, v, lam):
    seq = q1.shape[1]
    scale = HEAD_DIM ** -0.5
    kpos = jnp.arange(seq)

    def block(args):
        i, qb1, qb2 = args
        qpos = i * BLOCK_Q + jnp.arange(BLOCK_Q)
        causal = kpos[None, :] <= qpos[:, None]

        def probs(qb, k):
            sc = jnp.einsum('bqhd,bkhd->bhqk', qb, k).astype(jnp.float32) * scale
            return jax.nn.softmax(jnp.where(causal, sc, -jnp.inf), axis=-1)

        p = probs(qb1, k1) - lam * probs(qb2, k2)
        return jnp.einsum('bhqk,bkhe->bqhe', p.astype(v.dtype), v)

    out = lax.map(block, (jnp.arange(seq // BLOCK_Q), _to_blocks(q1), _to_blocks(q2)))
    return _from_blocks(out)


def forgetting_attention(q, k, v, logf):
    seq = q.shape[1]
    scale = HEAD_DIM ** -0.5
    c = jnp.cumsum(logf, axis=1)
    c_keys = jnp.transpose(c, (0, 2, 1))
    kpos = jnp.arange(seq)

    def block(args):
        i, qb, cb = args
        qpos = i * BLOCK_Q + jnp.arange(BLOCK_Q)
        causal = kpos[None, :] <= qpos[:, None]
        decay = jnp.transpose(cb, (0, 2, 1))[..., :, None] - c_keys[:, :, None, :]
        sc = jnp.einsum('bqhd,bkhd->bhqk', qb, k).astype(jnp.float32) * scale + decay
        p = jax.nn.softmax(jnp.where(causal, sc, -jnp.inf), axis=-1)
        return jnp.einsum('bhqk,bkhe->bqhe', p.astype(v.dtype), v)

    out = lax.map(block, (jnp.arange(seq // BLOCK_Q), _to_blocks(q), _to_blocks(c)))
    return _from_blocks(out)


def dilated_window_attention(q, k, v, window, dilation):
    b, seq, h, dh = q.shape
    n = window // dilation
    span = n * dilation
    padded = -(-seq // span) * span
    nb = padded // span
    m_len = padded // dilation
    scale = HEAD_DIM ** -0.5

    def strided(t):
        t = jnp.pad(t, ((0, 0), (0, padded - seq), (0, 0), (0, 0)))
        t = jnp.transpose(t.reshape(b, m_len, dilation, h, dh), (0, 2, 1, 3, 4))
        return t.reshape(b, dilation, nb, n, h, dh)

    def band(t):
        prev = jnp.pad(t, ((0, 0), (0, 0), (1, 0), (0, 0), (0, 0), (0, 0)))[:, :, :-1]
        return jnp.concatenate([prev, t], axis=3)

    qs, kb, vb = strided(q), band(strided(k)), band(strided(v))
    sc = jnp.einsum('bcnqhe,bcnkhe->bcnhqk', qs, kb).astype(jnp.float32) * scale
    qi = jnp.arange(n)[:, None]
    kj = jnp.arange(2 * n)[None, :]
    dist = n + qi - kj
    in_window = (dist >= 0) & (dist <= n)
    has_prev = (jnp.arange(nb)[:, None, None] > 0) | (kj[None] >= n)
    mask = (in_window[None] & has_prev)[:, None]
    sc = jnp.where(mask, sc, -jnp.inf)
    lse = jax.nn.logsumexp(sc, axis=-1)
    p = jnp.exp(sc - lse[..., None])
    o = jnp.einsum('bcnhqk,bcnkhe->bcnqhe', p.astype(v.dtype), vb)
    o = jnp.transpose(o.reshape(b, dilation, m_len, h, dh), (0, 2, 1, 3, 4)).reshape(b, padded, h, dh)[:, :seq]
    lse = jnp.transpose(lse, (0, 1, 2, 4, 3)).reshape(b, dilation, m_len, h)
    lse = jnp.transpose(lse, (0, 2, 1, 3)).reshape(b, padded, h)[:, :seq]
    return o, lse


def dilated_mixture(q, k, v):
    outs, lses = [], []
    for g, (window, dilation) in enumerate(C_PATTERNS):
        o, l = dilated_window_attention(q[:, :, g], k[:, :, g], v[:, :, g], window, dilation)
        outs.append(o)
        lses.append(l)
    wts = jax.nn.softmax(jnp.stack(lses, axis=0), axis=0)
    return jnp.einsum('gbsh,gbshe->bshe', wts.astype(q.dtype), jnp.stack(outs, axis=0))


def hybrid_mixer(x, positions, w_in, b_forget, diff_lambda, diff_subln, lam_init,
                 w_branch_a, w_branch_b, w_branch_c, w_gate, b_gate, w_out):
    b, s, _ = x.shape
    proj = x @ w_in
    qa, ka, va, qb, kb, vb, fb, qc, kc, vc = jnp.split(proj, IN_SPLITS, axis=-1)
    qa = rope(qa.reshape(b, s, 2 * A_HEADS, HEAD_DIM), positions).reshape(b, s, A_HEADS, 2, HEAD_DIM)
    ka = rope(ka.reshape(b, s, 2 * A_HEADS, HEAD_DIM), positions).reshape(b, s, A_HEADS, 2, HEAD_DIM)
    va = va.reshape(b, s, A_HEADS, 2 * HEAD_DIM)
    lf = diff_lambda.astype(jnp.float32)
    lam = jnp.exp(jnp.dot(lf[0], lf[1])) - jnp.exp(jnp.dot(lf[2], lf[3])) + lam_init
    oa = diff_attention(qa[:, :, :, 0], qa[:, :, :, 1], ka[:, :, :, 0], ka[:, :, :, 1], va, lam)
    oa = (rms_norm(oa, diff_subln) * (1.0 - lam_init)).reshape(b, s, A_OUT)
    logf = jax.nn.log_sigmoid(fb.astype(jnp.float32) + b_forget.astype(jnp.float32))
    ob = forgetting_attention(qb.reshape(b, s, B_HEADS, HEAD_DIM), kb.reshape(b, s, B_HEADS, HEAD_DIM),
                              vb.reshape(b, s, B_HEADS, HEAD_DIM), logf).reshape(b, s, B_OUT)
    ch = C_GROUPS * C_SLOTS
    qc = rope(qc.reshape(b, s, ch, HEAD_DIM), positions).reshape(b, s, C_GROUPS, C_SLOTS, HEAD_DIM)
    kc = rope(kc.reshape(b, s, ch, HEAD_DIM), positions).reshape(b, s, C_GROUPS, C_SLOTS, HEAD_DIM)
    vc = vc.reshape(b, s, C_GROUPS, C_SLOTS, HEAD_DIM)
    oc = dilated_mixture(qc, kc, vc).reshape(b, s, C_OUT)
    ga, gb, gc = jnp.split(jax.nn.sigmoid(x @ w_gate + b_gate), N_BRANCH, axis=-1)
    merged = ga * (oa @ w_branch_a) + gb * (ob @ w_branch_b) + gc * (oc @ w_branch_c)
    return merged @ w_out


def memory_cross_attention(x, mem, w_q, w_k, w_v, w_o):
    b, s, _ = x.shape
    m = mem.shape[1]
    q = (x @ w_q).reshape(b, s, X_HEADS, X_HEAD_DIM)
    k = (mem @ w_k).reshape(b, m, X_HEADS, X_HEAD_DIM)
    v = (mem @ w_v).reshape(b, m, X_HEADS, X_HEAD_DIM)
    sc = jnp.einsum('bqhd,bkhd->bhqk', q, k).astype(jnp.float32) * (X_HEAD_DIM ** -0.5)
    p = jax.nn.softmax(sc, axis=-1)
    o = jnp.einsum('bhqk,bkhd->bqhd', p.astype(v.dtype), v).reshape(b, s, D_MODEL)
    return o @ w_o


def hierarchical_moe(x, w_rg, b_rg, w_re, b_re, w_gate_up, w_up, w_down):
    b, s, d = x.shape
    t = x.reshape(b * s, d)
    g_logits = (t @ w_rg).astype(jnp.float32) + b_rg
    g_probs = jax.nn.softmax(g_logits, axis=-1)
    g_top, g_idx = lax.top_k(g_logits, 1)
    g_idx = g_idx[:, 0]
    g_gate = jnp.take_along_axis(g_probs, g_idx[:, None], axis=-1)[:, 0]
    e_logits = jnp.einsum('td,gde->tge', t, w_re).astype(jnp.float32) + b_re
    e_sel = jnp.take_along_axis(e_logits, g_idx[:, None, None], axis=1)[:, 0]
    top_v, top_i = lax.top_k(e_sel, EXPERT_TOPK)
    top_w = jax.nn.softmax(top_v, axis=-1)
    e_w = jnp.sum(jax.nn.one_hot(top_i, EXPERTS_PER_GROUP, dtype=jnp.float32) * top_w[..., None], axis=1)
    gate = jax.nn.one_hot(g_idx, N_GROUPS, dtype=jnp.float32)[:, :, None] * (g_gate[:, None] * e_w)[:, None, :]
    y = jnp.zeros_like(t)
    for g in range(N_GROUPS):
        h = jax.nn.silu(jnp.einsum('td,edf->tef', t, w_gate_up[g])) * jnp.einsum('td,edf->tef', t, w_up[g])
        y = y + jnp.einsum('tef,efd->td', h * gate[:, g, :, None].astype(h.dtype), w_down[g])
    return y.reshape(b, s, d)


def setup_inputs(seed: int = 0) -> dict:
    key = jax.random.key(seed)
    ks = iter(jax.random.split(key, 32))

    def nrm(shape, scale):
        return jax.random.normal(next(ks), shape, jnp.float32) * scale

    fan = D_MODEL ** -0.5
    L = DEPTH
    x = nrm((BATCH, SEQ, D_MODEL), 1.0)
    mem = nrm((BATCH, MEM_LEN, D_MODEL), 1.0)
    offsets = jax.random.randint(next(ks), (BATCH, 1), 0, 1024, dtype=jnp.int32)
    positions = offsets + jnp.arange(SEQ, dtype=jnp.int32)[None, :]
    return {
        "x": x,
        "mem": mem,
        "positions": positions,
        "w_in": nrm((L, D_MODEL, IN_COLS), fan),
        "b_forget": jax.random.uniform(next(ks), (L, B_HEADS), jnp.float32, FORGET_BIAS_LO, FORGET_BIAS_HI),
        "diff_lambda": nrm((L, 4, HEAD_DIM), 0.1),
        "diff_subln": 1.0 + nrm((L, 2 * HEAD_DIM), 0.02),
        "w_branch_a": nrm((L, A_OUT, D_MODEL), A_OUT ** -0.5 * DN_BETA),
        "w_branch_b": nrm((L, B_OUT, D_MODEL), B_OUT ** -0.5 * DN_BETA),
        "w_branch_c": nrm((L, C_OUT, D_MODEL), C_OUT ** -0.5 * DN_BETA),
        "w_gate": nrm((L, D_MODEL, N_BRANCH * D_MODEL), fan),
        "b_gate": nrm((L, N_BRANCH * D_MODEL), 0.02),
        "w_out": nrm((L, D_MODEL, D_MODEL), fan * DN_BETA),
        "w_xq": nrm((L, D_MODEL, D_MODEL), fan),
        "w_xk": nrm((L, D_MODEL, D_MODEL), fan),
        "w_xv": nrm((L, D_MODEL, D_MODEL), fan),
        "w_xo": nrm((L, D_MODEL, D_MODEL), fan * DN_BETA),
        "w_route_group": nrm((L, D_MODEL, N_GROUPS), fan),
        "b_route_group": nrm((L, N_GROUPS), 0.01),
        "w_route_expert": nrm((L, N_GROUPS, D_MODEL, EXPERTS_PER_GROUP), fan),
        "b_route_expert": nrm((L, N_GROUPS, EXPERTS_PER_GROUP), 0.01),
        "w_expert_gate": nrm((L, N_GROUPS, EXPERTS_PER_GROUP, D_MODEL, D_EXPERT), fan),
        "w_expert_up": nrm((L, N_GROUPS, EXPERTS_PER_GROUP, D_MODEL, D_EXPERT), fan),
        "w_expert_down": nrm((L, N_GROUPS, EXPERTS_PER_GROUP, D_EXPERT, D_MODEL), D_EXPERT ** -0.5 * DN_BETA),
        "ln_g": 1.0 + nrm((L, N_SUBLAYERS, D_MODEL), 0.02),
        "ln_b": nrm((L, N_SUBLAYERS, D_MODEL), 0.02),
    }


def reference(x, mem, positions, w_in, b_forget, diff_lambda, diff_subln, w_branch_a, w_branch_b,
              w_branch_c, w_gate, b_gate, w_out, w_xq, w_xk, w_xv, w_xo, w_route_group, b_route_group,
              w_route_expert, b_route_expert, w_expert_gate, w_expert_up, w_expert_down, ln_g, ln_b):
    for l in range(DEPTH):
        lam_init = 0.8 - 0.6 * math.exp(-0.3 * l)
        h = hybrid_mixer(x, positions, w_in[l], b_forget[l], diff_lambda[l], diff_subln[l], lam_init,
                         w_branch_a[l], w_branch_b[l], w_branch_c[l], w_gate[l], b_gate[l], w_out[l])
        x = layer_norm(DN_ALPHA * x + h, ln_g[l, 0], ln_b[l, 0])
        h = memory_cross_attention(x, mem, w_xq[l], w_xk[l], w_xv[l], w_xo[l])
        x = layer_norm(DN_ALPHA * x + h, ln_g[l, 1], ln_b[l, 1])
        h = hierarchical_moe(x, w_route_group[l], b_route_group[l], w_route_expert[l], b_route_expert[l],
                             w_expert_gate[l], w_expert_up[l], w_expert_down[l])
        x = layer_norm(DN_ALPHA * x + h, ln_g[l, 2], ln_b[l, 2])
    return x
```

```cpp
#include <hip/hip_runtime.h>
#include <stdint.h>
#include <math.h>

#define LAS __attribute__((address_space(3)))
#define GAS __attribute__((address_space(1)))
typedef unsigned short bf16_t;
typedef short bf16x8 __attribute__((ext_vector_type(8)));
typedef short s16x4 __attribute__((ext_vector_type(4)));
typedef float f32x2 __attribute__((ext_vector_type(2)));
typedef float f32x4 __attribute__((ext_vector_type(4)));
typedef float f32x16 __attribute__((ext_vector_type(16)));
typedef unsigned u32x2 __attribute__((ext_vector_type(2)));
typedef unsigned u32x4 __attribute__((ext_vector_type(4)));
typedef __bf16 bf16x2_t __attribute__((ext_vector_type(2)));

constexpr int NB = 8, SEQ = 4096, DM = 1024, T = NB * SEQ, MEMLEN = 256;
constexpr int IN_COLS = 5384, NPROJ = 5632;
constexpr float LOG2E = 1.4426950408889634f, LN2 = 0.6931471805599453f;
constexpr float DN_ALPHA = 1.4142135623730951f;
constexpr float LN_EPS = 1e-5f;
constexpr float QSCALE = 0.125f * LOG2E;
constexpr float XSCALE = 0.0625f * LOG2E;
constexpr int NBUCKET = 24, MAXRT = 152;

constexpr size_t MiB = 1u << 20;
constexpr size_t OFF_CTL = 0, CTL_BYTES = 1 * MiB;
constexpr size_t OFF_COS = 1 * MiB, OFF_SIN = 5 * MiB;
constexpr size_t OFF_LOGF = 9 * MiB;
constexpr size_t OFF_KBIAS = 10 * MiB;
constexpr size_t OFF_LSE = 11 * MiB;
constexpr size_t OFF_ROWTOK = 13 * MiB;
constexpr size_t OFF_ROWW = 13 * MiB + 256 * 1024;
constexpr size_t OFF_TOKINFO = 14 * MiB;
constexpr size_t OFF_KX = 15 * MiB, OFF_VX = 19 * MiB;
constexpr size_t OFF_MEMB = 23 * MiB;
constexpr size_t OFF_W = 27 * MiB;
constexpr size_t W_IN = 0, W_GATE = W_IN + (size_t)NPROJ * 1024 * 2, W_OUT = W_GATE + 6 * MiB, W_BA = W_OUT + 2 * MiB, W_BB = W_BA + 1 * MiB,
                 W_BC = W_BB + 1 * MiB, W_XQ = W_BC + MiB / 2, W_XK = W_XQ + 2 * MiB, W_XV = W_XK + 2 * MiB, W_XO = W_XV + 2 * MiB,
                 W_E1 = W_XO + 2 * MiB, W_DP = W_E1 + 16 * MiB, W_END = W_DP + 24 * MiB;
static_assert(W_END <= 70 * MiB, "weights");
constexpr size_t OFF_XB = 97 * MiB;
constexpr size_t OFF_PROJ = 161 * MiB;
constexpr size_t P_QA = OFF_PROJ, P_QB = P_QA + 32 * MiB, P_QC = P_QB + 32 * MiB, P_KA = P_QC + 48 * MiB, P_VA = P_KA + 32 * MiB,
                 P_KB = P_VA + 32 * MiB, P_VB = P_KB + 32 * MiB, P_KC = P_VB + 32 * MiB, P_VC = P_KC + 48 * MiB, P_END = P_VC + 48 * MiB;
static_assert(P_END == 497 * MiB, "proj map");
constexpr size_t P_OC = P_END - 16 * MiB;
constexpr size_t P_G = P_KA;
static_assert(P_G + (size_t)T * 3072 * 2 <= P_OC, "G overlay");
constexpr size_t P_XQ = OFF_PROJ, P_XO = OFF_PROJ + 64 * MiB;
constexpr size_t P_XG = OFF_PROJ, P_H = OFF_PROJ + 80 * MiB;
constexpr size_t WS_NEED = P_END;
constexpr int CW_BAR = 4096;
constexpr int CW_CNT = 16384;
constexpr int CW_CUR = 16384 + 64;

constexpr int RING_BYTES = 131072;
constexpr int MISC_OFF = RING_BYTES;
constexpr int LDS_BYTES = 147456;
constexpr int FA_SCR_OFF = 122880;

__device__ __forceinline__ unsigned pk2(float lo, float hi) { f32x2 v = {lo, hi}; bf16x2_t b = __builtin_convertvector(v, bf16x2_t); return __builtin_bit_cast(unsigned, b); }
__device__ __forceinline__ float bf2f(unsigned short h) { return __uint_as_float(((unsigned)h) << 16); }
__device__ __forceinline__ float wave_sum(float v) {
#pragma unroll
    for (int o = 1; o < 64; o <<= 1) v += __shfl_xor(v, o);
    return v;
}
#define LDS_WAIT() asm volatile("s_waitcnt lgkmcnt(0)" ::: "memory")

#define XB_TMO      128
#define XB_XCNT(j)  (256  + 64 * (j))
#define XB_XSUB(j)  (1280 + 64 * (j))
#define XB_XGEN(j)  (2304 + 64 * (j))
#define XB_TOP      3328
#define XB_TOPGEN   3392
#define XCD_BAR_WORDS 3456
#define XB_SPIN_CAP (1u << 18)
__device__ __forceinline__ unsigned xb_ld(unsigned* p)              { return __hip_atomic_load(p, __ATOMIC_RELAXED, __HIP_MEMORY_SCOPE_AGENT); }
__device__ __forceinline__ unsigned xb_add(unsigned* p, unsigned v) { return __hip_atomic_fetch_add(p, v, __ATOMIC_RELAXED, __HIP_MEMORY_SCOPE_AGENT); }
__device__ __forceinline__ unsigned xb_xcc_id() { return (unsigned)__builtin_amdgcn_s_getreg((3 << 11) | 20) & 0xFu; }
#define XB_SPIN(cond, bar) do { unsigned _sp = 0; while (cond) { __builtin_amdgcn_s_sleep(1); \
    if ((++_sp & 255u) == 0u) { if (xb_ld(&(bar)[XB_TMO])) break; if (_sp > XB_SPIN_CAP) { atomicAdd(&(bar)[XB_TMO], 1u); break; } } } } while (0)
struct XcdBarrier { unsigned* bar; unsigned x; volatile LAS unsigned* st; };
__device__ __forceinline__ XcdBarrier xcd_barrier_post(unsigned* bar, volatile LAS unsigned* st) {
    XcdBarrier b; b.bar = bar; b.x = xb_xcc_id(); b.st = st;
    if (threadIdx.x == 0) (void)xb_add(&bar[XB_XCNT(b.x)], 1u);
    return b;
}
__device__ __forceinline__ void xcd_barrier_complete(unsigned* bar, unsigned x, unsigned& nloc, unsigned& nx) {
    const unsigned G = gridDim.x * gridDim.y * gridDim.z;
    unsigned sum, cnt, mine, sp = 0u;
    for (;;) {
        sum = 0u; cnt = 0u; mine = 0u;
#pragma unroll
        for (unsigned j = 0; j < 16; ++j) { const unsigned c = xb_ld(&bar[XB_XCNT(j)]); sum += c; cnt += (c > 0u) ? 1u : 0u; mine = (j == x) ? c : mine; }
        if (sum == G) break;
        __builtin_amdgcn_s_sleep(1);
        if ((++sp & 255u) == 0u) { if (xb_ld(&bar[XB_TMO])) break; if (sp > XB_SPIN_CAP) { atomicAdd(&bar[XB_TMO], 1u); break; } }
    }
    nloc = mine > 0u ? mine : 1u; nx = cnt > 0u ? cnt : 1u;
}
__device__ __forceinline__ void xcd_barrier(const XcdBarrier& b) {
    asm volatile("s_waitcnt vmcnt(0)" ::: "memory");
    __syncthreads();
    if (threadIdx.x == 0) {
        unsigned* bar = b.bar;
        __builtin_amdgcn_s_waitcnt(0);
        unsigned nloc = b.st[0], nx = b.st[1];
        if (nloc == 0u) { xcd_barrier_complete(bar, b.x, nloc, nx); b.st[0] = nloc; b.st[1] = nx; }
        const unsigned old = xb_add(&bar[XB_XSUB(b.x)], 1u);
        const unsigned gen = old / nloc;
        if (old + 1u == (gen + 1u) * nloc) {
            __builtin_amdgcn_fence(__ATOMIC_RELEASE, "agent");
            asm volatile("s_waitcnt vmcnt(0)" ::: "memory");
            const unsigned og = xb_add(&bar[XB_TOP], 1u);
            const unsigned tg = og / nx;
            if (og + 1u == (tg + 1u) * nx) xb_add(&bar[XB_TOPGEN], 1u);
            else XB_SPIN(xb_ld(&bar[XB_TOPGEN]) == tg, bar);
            __builtin_amdgcn_fence(__ATOMIC_ACQUIRE, "agent");
            xb_add(&bar[XB_XGEN(b.x)], 1u);
            asm volatile("s_waitcnt vmcnt(0)" ::: "memory");
        } else {
            XB_SPIN(xb_ld(&bar[XB_XGEN(b.x)]) == gen, bar);
            __builtin_amdgcn_fence(__ATOMIC_ACQUIRE, "agent");
            asm volatile("s_waitcnt vmcnt(0)" ::: "memory");
        }
    }
    __syncthreads();
}

namespace pg8 {
constexpr int BM = 256, BK = 64, HALF = 128, HTB = HALF * BK * 2, STAGE_BYTES = 8 * HTB, NXCD = 8, WGM = 8;
__host__ __device__ __forceinline__ int lds_byte(int r, int c) { const int st = (r >> 4) * 2 + (c >> 5), rr = r & 15, cc = c & 31, ob = rr * 64 + cc * 2; return st * 1024 + (ob ^ (((ob >> 9) & 1) << 5)); }
__host__ __device__ __forceinline__ void stage_rc(int b, int& R, int& C) { const int st = b / 1024, sb = b % 1024, swz = sb ^ (((sb >> 9) & 1) << 5); R = (st >> 1) * 16 + swz / 64; C = (st & 1) * 32 + (swz % 64) / 2; }
__host__ __device__ __forceinline__ int perm32(int rho) { const int n = rho >> 4, i = rho & 15; return 8 * (i >> 2) + 4 * n + (i & 3); }

struct Unit { int pm, pn; const char* A; const char* B; };
struct Gemm { int lda, ldb, K; };

struct GridOrder {
    const char* A; const char* Bt; size_t astep, bstep; int nM, nN, nwg, G, c;
    __device__ __forceinline__ void init(const void* A_, int lda, const void* Bt_, int ldb, int M, int N, int G_, int c_) {
        A = (const char*)A_; Bt = (const char*)Bt_; astep = (size_t)BM * lda * 2; bstep = (size_t)BM * ldb * 2; nM = M / BM; nN = N / BM; nwg = nM * nN; G = G_; c = c_; }
    __device__ __forceinline__ bool next(int i, Unit& u) const {
        const long L = (long)i * G + c; if (L >= nwg) return false;
        int wgid = (int)L; { const int q = nwg / NXCD, r = nwg % NXCD, xcd = wgid % NXCD, off = wgid / NXCD; wgid = (xcd < r ? xcd * (q + 1) : r * (q + 1) + (xcd - r) * q) + off; }
        const int nig = WGM * nN, gid = wgid / nig, fm = gid * WGM, gsz = (nM - fm) < WGM ? (nM - fm) : WGM;
        u.pm = fm + ((wgid % nig) % gsz); u.pn = (wgid % nig) / gsz; u.A = A + (size_t)u.pm * astep; u.B = Bt + (size_t)u.pn * bstep; return true;
    }
};

__device__ __forceinline__ unsigned cvt_pk_bf16(float lo, float hi) { return pk2(lo, hi); }

template <class Epi, class Sched>
__device__ __forceinline__ void gemm_phase(LAS unsigned char* lds, const Gemm g, const Sched& S, const Epi& E) {
    int tid = threadIdx.x; asm volatile("" : "+v"(tid));
    const int wid = __builtin_amdgcn_readfirstlane(tid >> 6), lane = tid & 63, wr = wid >> 2, wc = wid & 3, fr = lane & 15, fq = lane >> 4;
    const int K = g.K, nt = K / BK;
    unsigned voffA[2], voffB[2];
#pragma unroll
    for (int i = 0; i < 2; ++i) { int R, C; stage_rc(tid * 16 + i * 8192, R, C); const int Rb = (R & ~31) + perm32(R & 31);
        voffA[i] = (unsigned)(R * g.lda + C) * 2u; voffB[i] = (unsigned)(Rb * g.ldb + C) * 2u; }
    const size_t kstep = (size_t)(BK * 2);
    const size_t hstepA = (size_t)HALF * g.lda * 2, hstepB = (size_t)HALF * g.ldb * 2;
    const unsigned ldsw = (unsigned)wid * 1024u;
    const int aoff = lds_byte(wr * 64 + fr, fq * 8), boff = lds_byte(wc * 32 + fr, fq * 8);
#define PG8_SA(b, h) (((b) * 2 + (h)) * HTB)
#define PG8_SB(b, h) ((4 + (b) * 2 + (h)) * HTB)
#define PG8_STAGE(bufoff, gbase, voff) do { _Pragma("unroll") for (int _i = 0; _i < 2; ++_i) \
        __builtin_amdgcn_global_load_lds((const unsigned*)((const char*)(gbase) + (voff)[_i]), (LAS unsigned*)(lds + (bufoff) + ldsw + _i * 8192), 16, 0, 0); } while (0)
#define PG8_LDA(dst, b, h) do { _Pragma("unroll") for (int m = 0; m < 4; ++m) _Pragma("unroll") for (int k = 0; k < 2; ++k) dst[m][k] = *(const LAS bf16x8*)(lds + PG8_SA(b, h) + aoff + m * 2048 + k * 1024); } while (0)
#define PG8_LDB(dst, b, h) do { _Pragma("unroll") for (int n = 0; n < 2; ++n) _Pragma("unroll") for (int k = 0; k < 2; ++k) dst[n][k] = *(const LAS bf16x8*)(lds + PG8_SB(b, h) + boff + n * 2048 + k * 1024); } while (0)
#define PG8_MMA(ai, bj, At, Bt) do { __builtin_amdgcn_s_setprio(1); _Pragma("unroll") for (int m = 0; m < 4; ++m) _Pragma("unroll") for (int n = 0; n < 2; ++n) _Pragma("unroll") for (int k = 0; k < 2; ++k) \
        acc[ai][bj][m][n] = __builtin_amdgcn_mfma_f32_16x16x32_bf16(Bt[n][k], At[m][k], acc[ai][bj][m][n], 0, 0, 0); __builtin_amdgcn_s_setprio(0); } while (0)
#define PG8_WAIT_V(n) asm volatile("s_waitcnt vmcnt(" #n ")" ::: "memory")
#define PG8_WAIT_L(n) asm volatile("s_waitcnt lgkmcnt(" #n ")" ::: "memory")
#define PG8_BAR __builtin_amdgcn_s_barrier()
#define PG8_SCHED __builtin_amdgcn_sched_barrier(0)
    Unit cur, nxt; int ui = 0;
    if (!S.next(0, cur)) return;
    f32x4 acc[2][2][4][2];
    float zf = 0.f; asm volatile("" : "+v"(zf));
#pragma unroll
    for (int a = 0; a < 2; ++a)
#pragma unroll
        for (int b = 0; b < 2; ++b)
#pragma unroll
            for (int m = 0; m < 4; ++m)
#pragma unroll
                for (int n = 0; n < 2; ++n) acc[a][b][m][n] = (f32x4){zf, zf, zf, zf};
    const char* cA = cur.A; const char* cB = cur.B;
    PG8_STAGE(PG8_SB(0, 0), cB, voffB); PG8_STAGE(PG8_SB(0, 1), cB + hstepB, voffB); PG8_STAGE(PG8_SA(0, 0), cA, voffA); PG8_STAGE(PG8_SA(0, 1), cA + hstepA, voffA);
    if (wr == 1) PG8_BAR;
    PG8_WAIT_V(2); PG8_BAR;
    PG8_STAGE(PG8_SB(1, 0), cB + kstep, voffB); PG8_STAGE(PG8_SA(1, 0), cA + kstep, voffA); PG8_STAGE(PG8_SB(1, 1), cB + hstepB + kstep, voffB);
    PG8_WAIT_V(6); PG8_BAR;
    for (;;) {
        const bool has_next = S.next(ui + 1, nxt);
        const char* nA = has_next ? nxt.A : cA; const char* nB = has_next ? nxt.B : cB;
        for (int t = 0; t < nt; t += 2) {
            const bool last = (t == nt - 2);
            bf16x8 At[4][2], B0[2][2], B1[2][2];
            const char* a1 = cA + (size_t)(t + 1) * kstep;
            const char* a2 = last ? nA : cA + (size_t)(t + 2) * kstep; const char* b2 = last ? nB : cB + (size_t)(t + 2) * kstep;
            const char* a3 = a2 + kstep; const char* b3 = b2 + kstep;
            PG8_LDB(B0, 0, 0); PG8_LDB(B1, 0, 1); PG8_SCHED; PG8_LDA(At, 0, 0); PG8_STAGE(PG8_SA(1, 1), a1 + hstepA, voffA);
            PG8_WAIT_V(8); PG8_WAIT_L(0); PG8_BAR; PG8_MMA(0, 0, At, B0); PG8_MMA(0, 1, At, B1); PG8_BAR; PG8_SCHED;
            PG8_LDA(At, 0, 1); PG8_STAGE(PG8_SB(0, 0), b2, voffB); PG8_STAGE(PG8_SB(0, 1), b2 + hstepB, voffB); PG8_STAGE(PG8_SA(0, 0), a2, voffA);
            PG8_WAIT_V(8); PG8_WAIT_L(0); PG8_BAR; PG8_MMA(1, 0, At, B0); PG8_MMA(1, 1, At, B1); PG8_BAR; PG8_SCHED;
            PG8_LDB(B0, 1, 0); PG8_LDB(B1, 1, 1); PG8_SCHED; PG8_LDA(At, 1, 0); PG8_STAGE(PG8_SA(0, 1), a2 + hstepA, voffA);
            PG8_WAIT_V(8); PG8_WAIT_L(0); PG8_BAR; PG8_MMA(0, 0, At, B0); PG8_MMA(0, 1, At, B1); PG8_BAR; PG8_SCHED;
            PG8_LDA(At, 1, 1); PG8_STAGE(PG8_SB(1, 0), b3, voffB); PG8_STAGE(PG8_SB(1, 1), b3 + hstepB, voffB); PG8_STAGE(PG8_SA(1, 0), a3, voffA);
            PG8_WAIT_V(8); PG8_WAIT_L(0); PG8_BAR; PG8_MMA(1, 0, At, B0); PG8_MMA(1, 1, At, B1); PG8_BAR; PG8_SCHED;
        }
        if (wr == 0) PG8_BAR;
        E(acc, cur, wr, wc, fr, fq);
        if (!has_next) break;
#pragma unroll
        for (int a = 0; a < 2; ++a)
#pragma unroll
            for (int b = 0; b < 2; ++b)
#pragma unroll
                for (int m = 0; m < 4; ++m)
#pragma unroll
                    for (int n = 0; n < 2; ++n) acc[a][b][m][n] = (f32x4){zf, zf, zf, zf};
        cur = nxt; cA = nA; cB = nB; ++ui;
        if (wr == 1) PG8_BAR;
    }
    PG8_WAIT_V(0);
    PG8_BAR;
#undef PG8_SA
#undef PG8_SB
#undef PG8_STAGE
#undef PG8_LDA
#undef PG8_LDB
#undef PG8_MMA
#undef PG8_WAIT_V
#undef PG8_WAIT_L
#undef PG8_BAR
#undef PG8_SCHED
}

struct EpiStore {
    bf16_t* O; int ldc; const float* bias; float scale; int act;
    __device__ __forceinline__ void operator()(const f32x4 (&acc)[2][2][4][2], const Unit& u, int wr, int wc, int fr, int fq) const {
        const int row0 = u.pm * BM + wr * 64 + fr, col0 = u.pn * BM + wc * 32 + 8 * fq;
        f32x4 bv[2][2];
#pragma unroll
        for (int bj = 0; bj < 2; ++bj)
#pragma unroll
            for (int n = 0; n < 2; ++n) bv[bj][n] = bias ? *(const f32x4*)(bias + col0 + bj * HALF + 4 * n) : (f32x4){0.f, 0.f, 0.f, 0.f};
#pragma unroll
        for (int ai = 0; ai < 2; ++ai)
#pragma unroll
            for (int m = 0; m < 4; ++m) { bf16_t* rowp = O + (size_t)(row0 + ai * HALF + m * 16) * ldc + col0;
#pragma unroll
                for (int bj = 0; bj < 2; ++bj) { f32x4 v0 = acc[ai][bj][m][0] + bv[bj][0], v1 = acc[ai][bj][m][1] + bv[bj][1];
                    if (act == 1) {
#pragma unroll
                        for (int i = 0; i < 4; ++i) { v0[i] = 1.f / (1.f + __expf(-v0[i])); v1[i] = 1.f / (1.f + __expf(-v1[i])); } }
                    v0 = v0 * scale; v1 = v1 * scale; u32x4 w; w.x = cvt_pk_bf16(v0[0], v0[1]); w.y = cvt_pk_bf16(v0[2], v0[3]); w.z = cvt_pk_bf16(v1[0], v1[1]); w.w = cvt_pk_bf16(v1[2], v1[3]);
                    *(u32x4*)(rowp + bj * HALF) = w; }
                if (m & 1) asm volatile("" ::: "memory"); }
    }
};

struct EpiProj {
    unsigned char* ws; const float* cosT; const float* sinT; const float* bforget; float* logf;
    __device__ __forceinline__ void operator()(const f32x4 (&acc)[2][2][4][2], const Unit& u, int wr, int wc, int fr, int fq) const {
        const int pn = u.pn, row0 = u.pm * BM + wr * 64 + fr;
        if (pn == 21) {
            if (wc == 0 && fq == 0) {
#pragma unroll
                for (int ai = 0; ai < 2; ++ai)
#pragma unroll
                    for (int m = 0; m < 4; ++m) { const int r = row0 + ai * HALF + m * 16;
#pragma unroll
                        for (int n = 0; n < 2; ++n) { f32x4 v = acc[ai][0][m][n] + *(const f32x4*)(bforget + 4 * n); f32x4 o;
#pragma unroll
                            for (int i = 0; i < 4; ++i) { const float z = v[i]; o[i] = fminf(z, 0.f) - log1pf(__expf(-fabsf(z))); }
                            *(f32x4*)(logf + (size_t)r * 8 + 4 * n) = o; } }
            }
            return;
        }
        size_t off; int ld, tcol; bool rope; float sc = 1.f;
        if (pn < 2)       { off = P_QA; ld = 512; tcol = pn * 256;        rope = true;  sc = QSCALE; }
        else if (pn < 4)  { off = P_KA; ld = 512; tcol = (pn - 2) * 256;  rope = true; }
        else if (pn < 6)  { off = P_VA; ld = 512; tcol = (pn - 4) * 256;  rope = false; }
        else if (pn < 8)  { off = P_QB; ld = 512; tcol = (pn - 6) * 256;  rope = false; sc = QSCALE; }
        else if (pn < 10) { off = P_KB; ld = 512; tcol = (pn - 8) * 256;  rope = false; }
        else if (pn < 12) { off = P_VB; ld = 512; tcol = (pn - 10) * 256; rope = false; }
        else if (pn < 15) { off = P_QC; ld = 768; tcol = (pn - 12) * 256; rope = true;  sc = QSCALE; }
        else if (pn < 18) { off = P_KC; ld = 768; tcol = (pn - 15) * 256; rope = true; }
        else              { off = P_VC; ld = 768; tcol = (pn - 18) * 256; rope = false; }
        bf16_t* O = (bf16_t*)(ws + off);
        if (!rope) {
            const int col0 = tcol + wc * 32 + 8 * fq;
#pragma unroll
            for (int ai = 0; ai < 2; ++ai)
#pragma unroll
                for (int m = 0; m < 4; ++m) { bf16_t* rowp = O + (size_t)(row0 + ai * HALF + m * 16) * ld + col0;
#pragma unroll
                    for (int bj = 0; bj < 2; ++bj) { const f32x4 v0 = acc[ai][bj][m][0] * sc, v1 = acc[ai][bj][m][1] * sc;
                        u32x4 w; w.x = cvt_pk_bf16(v0[0], v0[1]); w.y = cvt_pk_bf16(v0[2], v0[3]); w.z = cvt_pk_bf16(v1[0], v1[1]); w.w = cvt_pk_bf16(v1[2], v1[3]);
                        *(u32x4*)(rowp + bj * HALF) = w; } }
        } else {
            const int col0 = tcol + wc * 64 + 8 * fq;
#pragma unroll
            for (int ai = 0; ai < 2; ++ai)
#pragma unroll
                for (int m = 0; m < 4; ++m) { const int r = row0 + ai * HALF + m * 16; bf16_t* rowp = O + (size_t)r * ld + col0;
                    const f32x4 c0 = *(const f32x4*)(cosT + (size_t)r * 32 + 8 * fq), c1 = *(const f32x4*)(cosT + (size_t)r * 32 + 8 * fq + 4);
                    const f32x4 s0 = *(const f32x4*)(sinT + (size_t)r * 32 + 8 * fq), s1 = *(const f32x4*)(sinT + (size_t)r * 32 + 8 * fq + 4);
                    const f32x4 x10 = acc[ai][0][m][0], x11 = acc[ai][0][m][1], x20 = acc[ai][1][m][0], x21 = acc[ai][1][m][1];
                    const f32x4 a0 = (x10 * c0 - x20 * s0) * sc, a1 = (x11 * c1 - x21 * s1) * sc, b0 = (x20 * c0 + x10 * s0) * sc, b1 = (x21 * c1 + x11 * s1) * sc;
                    u32x4 w; w.x = cvt_pk_bf16(a0[0], a0[1]); w.y = cvt_pk_bf16(a0[2], a0[3]); w.z = cvt_pk_bf16(a1[0], a1[1]); w.w = cvt_pk_bf16(a1[2], a1[3]);
                    *(u32x4*)(rowp) = w;
                    w.x = cvt_pk_bf16(b0[0], b0[1]); w.y = cvt_pk_bf16(b0[2], b0[3]); w.z = cvt_pk_bf16(b1[0], b1[1]); w.w = cvt_pk_bf16(b1[2], b1[3]);
                    *(u32x4*)(rowp + 32) = w;
                    asm volatile("" ::: "memory"); }
        }
    }
};

struct EpiGate {
    bf16_t* G; int br;
    __device__ __forceinline__ void operator()(const f32x4 (&acc)[2][2][4][2], const Unit& u, int wr, int wc, int fr, int fq) const {
        const int row0 = u.pm * BM + wr * 64 + fr, col0 = u.pn * BM + wc * 32 + 8 * fq;
#pragma unroll
        for (int ai = 0; ai < 2; ++ai)
#pragma unroll
            for (int m = 0; m < 4; ++m) { bf16_t* rowp = G + (size_t)(row0 + ai * HALF + m * 16) * 3072 + col0;
#pragma unroll
                for (int bj = 0; bj < 2; ++bj) {
                    const u32x4 gw = *(const u32x4*)(rowp + br * 1024 + bj * HALF);
                    float v[8];
#pragma unroll
                    for (int i = 0; i < 4; ++i) { v[i] = acc[ai][bj][m][0][i]; v[4 + i] = acc[ai][bj][m][1][i]; }
#pragma unroll
                    for (int i = 0; i < 4; ++i) { v[2 * i] *= __uint_as_float(gw[i] << 16); v[2 * i + 1] *= __uint_as_float(gw[i] & 0xffff0000u); }
                    if (br > 0) { const u32x4 pw = *(const u32x4*)(rowp + bj * HALF);
#pragma unroll
                        for (int i = 0; i < 4; ++i) { v[2 * i] += __uint_as_float(pw[i] << 16); v[2 * i + 1] += __uint_as_float(pw[i] & 0xffff0000u); } }
                    u32x4 w; w.x = cvt_pk_bf16(v[0], v[1]); w.y = cvt_pk_bf16(v[2], v[3]); w.z = cvt_pk_bf16(v[4], v[5]); w.w = cvt_pk_bf16(v[6], v[7]);
                    *(u32x4*)(rowp + bj * HALF) = w; }
                asm volatile("" ::: "memory"); }
    }
};

struct EpiResid {
    const float* xres; float* out; const int* rowtok;
    __device__ __forceinline__ void operator()(const f32x4 (&acc)[2][2][4][2], const Unit& u, int wr, int wc, int fr, int fq) const {
        const int row0 = u.pm * BM + wr * 64 + fr, col0 = u.pn * BM + wc * 32 + 8 * fq;
#pragma unroll
        for (int ai = 0; ai < 2; ++ai)
#pragma unroll
            for (int m = 0; m < 4; ++m) { const int r = row0 + ai * HALF + m * 16; const int tok = rowtok ? rowtok[r] : r;
                if (tok >= 0) { const size_t o = (size_t)tok * DM + col0;
#pragma unroll
                    for (int bj = 0; bj < 2; ++bj)
#pragma unroll
                        for (int n = 0; n < 2; ++n) { const f32x4 x = *(const f32x4*)(xres + o + bj * HALF + 4 * n); *(f32x4*)(out + o + bj * HALF + 4 * n) = x * DN_ALPHA + acc[ai][bj][m][n]; } }
                asm volatile("" ::: "memory"); }
    }
};

struct EpiSwiglu {
    bf16_t* H; const float* roww;
    __device__ __forceinline__ void operator()(const f32x4 (&acc)[2][2][4][2], const Unit& u, int wr, int wc, int fr, int fq) const {
        const int slot = u.pn >> 1, jh = u.pn & 1, row0 = u.pm * BM + wr * 64 + fr, col0 = slot * 256 + jh * 128 + wc * 32 + 8 * fq;
#pragma unroll
        for (int ai = 0; ai < 2; ++ai)
#pragma unroll
            for (int m = 0; m < 4; ++m) { const int r = row0 + ai * HALF + m * 16; const float w = roww[(size_t)r * 2 + slot]; float v[8];
#pragma unroll
                for (int n = 0; n < 2; ++n)
#pragma unroll
                    for (int i = 0; i < 4; ++i) { const float gt = acc[ai][0][m][n][i], up = acc[ai][1][m][n][i]; v[4 * n + i] = gt / (1.f + __expf(-gt)) * up * w; }
                u32x4 o; o.x = cvt_pk_bf16(v[0], v[1]); o.y = cvt_pk_bf16(v[2], v[3]); o.z = cvt_pk_bf16(v[4], v[5]); o.w = cvt_pk_bf16(v[6], v[7]);
                *(u32x4*)(H + (size_t)r * 512 + col0) = o; }
    }
};
}

namespace fa {
__device__ __forceinline__ int crow(int r, int hi) { return (r & 3) + 8 * (r >> 2) + 4 * hi; }
__device__ __forceinline__ s16x4 vtr(const LAS unsigned char* p) { return __builtin_bit_cast(s16x4, __builtin_amdgcn_ds_read_tr16_b64_v4i16((LAS s16x4*)p)); }

struct Prm {
    const bf16_t* Q; const bf16_t* K; const bf16_t* V;
    int qld, kld, vld;
    int rs;
    int q0;
    int kt0, kt1;
    int causal, win;
    const float* kbias;
};

template <int DQK, int DV, bool BIAS, bool QREG = true>
__device__ __forceinline__ void pass(LAS unsigned char* lds, const Prm& p, f32x16 (&o)[DV / 32], float& m_out, float& l_out) {
    constexpr int KROW = DQK * 2 + 16, VROW = DV * 2 + 64, KSZ = 64 * KROW, VSZ = 64 * VROW, BUFSZ = KSZ + VSZ;
    constexpr int KCH = DQK / 8, NKL = 64 * KCH / 512, VCH = DV / 8, NVL = 64 * VCH / 512;
    static_assert(2 * BUFSZ <= FA_SCR_OFF, "flash LDS");
    int tid = threadIdx.x; asm volatile("" : "+v"(tid));
    const int lane = tid & 63, wid = __builtin_amdgcn_readfirstlane(tid >> 6), r32 = lane & 31, hi = lane >> 5;
    const int qw0 = p.q0 + wid * 32, qi = qw0 + r32;
    bf16x8 qf[QREG ? DQK / 16 : 1];
    const bf16_t* qrow = p.Q + (size_t)qi * p.rs * p.qld + hi * 8;
    if (QREG) {
#pragma unroll
      for (int ks = 0; ks < DQK / 16; ++ks) qf[ks] = *(const bf16x8*)(qrow + ks * 16); }
#pragma unroll
    for (int db = 0; db < DV / 32; ++db)
#pragma unroll
        for (int r = 0; r < 16; ++r) o[db][r] = 0.f;
    float mrun = -1e30f, lrun = 0.f;
    LAS float* sc = (LAS float*)(lds + FA_SCR_OFF) + wid * 32;
    int kgo[NKL], klo[NKL], vgo[NVL], vlo[NVL];
#pragma unroll
    for (int i = 0; i < NKL; ++i) { const int cid = tid + 512 * i, row = cid / KCH, ch = cid % KCH; kgo[i] = row; klo[i] = row * KROW + ch * 16; kgo[i] = row * 65536 + ch * 8; }
#pragma unroll
    for (int i = 0; i < NVL; ++i) { const int cid = tid + 512 * i, row = cid / VCH, ch = cid % VCH; vlo[i] = KSZ + row * VROW + ch * 16; vgo[i] = row * 65536 + ch * 8; }
    u32x4 kreg[NKL], vreg[NVL];
#define FA_GLOAD(kt) do { \
        _Pragma("unroll") for (int i = 0; i < NKL; ++i) kreg[i] = *(const u32x4*)(p.K + (size_t)((kt) * 64 + (kgo[i] >> 16)) * p.rs * p.kld + (kgo[i] & 0xffff)); \
        _Pragma("unroll") for (int i = 0; i < NVL; ++i) vreg[i] = *(const u32x4*)(p.V + (size_t)((kt) * 64 + (vgo[i] >> 16)) * p.rs * p.vld + (vgo[i] & 0xffff)); } while (0)
#define FA_LSTORE(buf) do { \
        _Pragma("unroll") for (int i = 0; i < NKL; ++i) *(LAS u32x4*)(lds + (buf) * BUFSZ + klo[i]) = kreg[i]; \
        _Pragma("unroll") for (int i = 0; i < NVL; ++i) *(LAS u32x4*)(lds + (buf) * BUFSZ + vlo[i]) = vreg[i]; } while (0)
    FA_GLOAD(p.kt0); FA_LSTORE(0);
    __syncthreads();
    const int vboff = KSZ + (((lane & 15) >> 2) + 4 * hi) * VROW + (16 * ((lane >> 4) & 1) + 4 * (lane & 3)) * 2;
    for (int kt = p.kt0; kt < p.kt1; ++kt) {
        const int cur = (kt - p.kt0) & 1;
        const bool more = (kt + 1 < p.kt1);
        if (more) FA_GLOAD(kt + 1);
        const int k0 = kt * 64;
        const bool skip = p.causal && (k0 > qw0 + 31 || k0 + 63 < qw0 - p.win);
        if (!skip) {
            f32x16 p0, p1;
#pragma unroll
            for (int r = 0; r < 16; ++r) { p0[r] = 0.f; p1[r] = 0.f; }
            const LAS unsigned char* kb = lds + cur * BUFSZ + r32 * KROW + hi * 16;
            const bf16_t* qrow_t = qrow; asm volatile("" : "+v"(qrow_t));
#pragma unroll
            for (int ks = 0; ks < DQK / 16; ++ks) {
                const bf16x8 a0 = *(const LAS bf16x8*)(kb + ks * 32), a1 = *(const LAS bf16x8*)(kb + 32 * KROW + ks * 32);
                const bf16x8 qk = QREG ? qf[QREG ? ks : 0] : *(const bf16x8*)(qrow_t + ks * 16);
                p0 = __builtin_amdgcn_mfma_f32_32x32x16_bf16(a0, qk, p0, 0, 0, 0);
                p1 = __builtin_amdgcn_mfma_f32_32x32x16_bf16(a1, qk, p1, 0, 0, 0);
            }
            if (BIAS) {
                const float* kbp = p.kbias + k0 + 4 * hi;
#pragma unroll
                for (int j = 0; j < 4; ++j) { const f32x4 b0 = *(const f32x4*)(kbp + 8 * j), b1 = *(const f32x4*)(kbp + 32 + 8 * j);
#pragma unroll
                    for (int i = 0; i < 4; ++i) { p0[4 * j + i] += b0[i]; p1[4 * j + i] += b1[i]; } }
            }
            const bool need_mask = p.causal && (k0 + 63 > qw0 || k0 < qw0 + 31 - p.win);
            if (need_mask) {
                const int lo = qi - p.win;
#pragma unroll
                for (int r = 0; r < 16; ++r) { const int key = k0 + crow(r, hi);
                    if (key > qi || key < lo) p0[r] = -INFINITY;
                    if (key + 32 > qi || key + 32 < lo) p1[r] = -INFINITY; }
            }
            float mx = fmaxf(p0[0], p1[0]);
#pragma unroll
            for (int r = 1; r < 16; ++r) mx = fmaxf(mx, fmaxf(p0[r], p1[r]));
            mx = fmaxf(mx, __shfl_xor(mx, 32));
            const float mnew = fmaxf(mrun, mx), alpha = __builtin_amdgcn_exp2f(mrun - mnew);
            mrun = mnew;
            float rs = 0.f;
#pragma unroll
            for (int r = 0; r < 16; ++r) { p0[r] = __builtin_amdgcn_exp2f(p0[r] - mnew); p1[r] = __builtin_amdgcn_exp2f(p1[r] - mnew); rs += p0[r] + p1[r]; }
            lrun = lrun * alpha + rs;
            if (hi == 0) sc[r32] = alpha;
            bf16x8 pa[4];
            { u32x4 w;
              w.x = pk2(p0[0], p0[1]); w.y = pk2(p0[2], p0[3]); w.z = pk2(p0[4], p0[5]); w.w = pk2(p0[6], p0[7]); pa[0] = __builtin_bit_cast(bf16x8, w);
              w.x = pk2(p0[8], p0[9]); w.y = pk2(p0[10], p0[11]); w.z = pk2(p0[12], p0[13]); w.w = pk2(p0[14], p0[15]); pa[1] = __builtin_bit_cast(bf16x8, w);
              w.x = pk2(p1[0], p1[1]); w.y = pk2(p1[2], p1[3]); w.z = pk2(p1[4], p1[5]); w.w = pk2(p1[6], p1[7]); pa[2] = __builtin_bit_cast(bf16x8, w);
              w.x = pk2(p1[8], p1[9]); w.y = pk2(p1[10], p1[11]); w.z = pk2(p1[12], p1[13]); w.w = pk2(p1[14], p1[15]); pa[3] = __builtin_bit_cast(bf16x8, w); }
#pragma unroll
            for (int j = 0; j < 4; ++j) { const f32x4 a4 = *(const LAS f32x4*)(sc + 8 * j + 4 * hi);
#pragma unroll
                for (int db = 0; db < DV / 32; ++db)
#pragma unroll
                    for (int i = 0; i < 4; ++i) o[db][4 * j + i] *= a4[i]; }
            const LAS unsigned char* vb = lds + cur * BUFSZ + vboff;
#pragma unroll
            for (int sp = 0; sp < 4; ++sp)
#pragma unroll
                for (int db = 0; db < DV / 32; ++db) {
                    const s16x4 lo4 = vtr(vb + (16 * sp) * VROW + db * 64), hi4 = vtr(vb + (16 * sp + 8) * VROW + db * 64);
                    const bf16x8 vf = (bf16x8){lo4[0], lo4[1], lo4[2], lo4[3], hi4[0], hi4[1], hi4[2], hi4[3]};
                    o[db] = __builtin_amdgcn_mfma_f32_32x32x16_bf16(pa[sp], vf, o[db], 0, 0, 0);
                }
        }
        if (more) FA_LSTORE(cur ^ 1);
        __syncthreads();
    }
#undef FA_GLOAD
#undef FA_LSTORE
    m_out = mrun; l_out = lrun;
}

template <int NDB>
__device__ __forceinline__ float normalise(LAS unsigned char* lds, f32x16 (&o)[NDB], float l) {
    const int lane = threadIdx.x & 63, wid = __builtin_amdgcn_readfirstlane(threadIdx.x >> 6), r32 = lane & 31, hi = lane >> 5;
    LAS float* sc = (LAS float*)(lds + FA_SCR_OFF) + wid * 32;
    const float lt = l + __shfl_xor(l, 32);
    if (hi == 0) sc[r32] = 1.f / lt;
#pragma unroll
    for (int j = 0; j < 4; ++j) { const f32x4 a4 = *(const LAS f32x4*)(sc + 8 * j + 4 * hi);
#pragma unroll
        for (int db = 0; db < NDB; ++db)
#pragma unroll
            for (int i = 0; i < 4; ++i) o[db][4 * j + i] *= a4[i]; }
    return lt;
}
template <int NDB>
__device__ __forceinline__ void store_o(const f32x16 (&o)[NDB], bf16_t* O, int old, int rs, int q0) {
    const int lane = threadIdx.x & 63, wid = __builtin_amdgcn_readfirstlane(threadIdx.x >> 6), r32 = lane & 31, hi = lane >> 5;
#pragma unroll
    for (int r = 0; r < 16; ++r) { bf16_t* rowp = O + (size_t)(q0 + wid * 32 + crow(r, hi)) * rs * old + r32;
#pragma unroll
        for (int db = 0; db < NDB; ++db) rowp[db * 32] = (bf16_t)(pk2(o[db][r], 0.f) & 0xffffu); }
}
}

struct Args {
    const float* x; const float* mem; const int* positions;
    const float* w_in; const float* b_forget; const float* diff_lambda; const float* diff_subln;
    const float* w_branch_a; const float* w_branch_b; const float* w_branch_c; const float* w_gate; const float* b_gate; const float* w_out;
    const float* w_xq; const float* w_xk; const float* w_xv; const float* w_xo;
    const float* w_rg; const float* b_rg; const float* w_re; const float* b_re;
    const float* w_eg; const float* w_eu; const float* w_ed; const float* ln_g; const float* ln_b;
    float* out; unsigned char* ws;
};

__device__ __forceinline__ void tr_item(const float* W, int ldw, int k0, int c0, int ncv, bf16_t* WT, int ldt, int r0, int kk0, LAS float* scr, int lane) {
    const int c = lane & 31;
#pragma unroll 8
    for (int i = 0; i < 32; ++i) { const int kk = 2 * i + (lane >> 5); scr[kk * 33 + c] = (c < ncv) ? W[(size_t)(k0 + kk) * ldw + c0 + c] : 0.f; }
    LDS_WAIT(); asm volatile("" ::: "memory");
    const int c8 = lane & 7;
#pragma unroll
    for (int j = 0; j < 4; ++j) { const int n = (lane >> 3) + 8 * j; const LAS float* s = scr + (8 * c8) * 33 + n;
        u32x4 o; o.x = pk2(s[0 * 33], s[1 * 33]); o.y = pk2(s[2 * 33], s[3 * 33]); o.z = pk2(s[4 * 33], s[5 * 33]); o.w = pk2(s[6 * 33], s[7 * 33]);
        *(u32x4*)(WT + (size_t)(r0 + n) * ldt + kk0 + 8 * c8) = o; }
    LDS_WAIT(); asm volatile("" ::: "memory");
}

__device__ __forceinline__ void convert_layer(const Args& a, int l, LAS unsigned char* lds, int gw, int NGW, int wave, int lane) {
    LAS float* scr = (LAS float*)(lds + wave * 16384);
    bf16_t* Wb = (bf16_t*)(a.ws + OFF_W);
    constexpr int N0 = 176 * 16, N1 = 96 * 16, N2 = 512, N7 = 256, N9 = 128, N10 = 4096, N11 = 6144;
    constexpr int TOTAL = N0 + N1 + 5 * N2 + 2 * N7 + N9 + N10 + N11;
    for (int it = gw; it < TOTAL; it += NGW) {
        int r = it;
        if (r < N0) {
            const int grp = r >> 4, kb = r & 15, t = grp >> 3, q = grp & 7; int c0, ncv = 32;
            if (t == 21) { c0 = 3072; ncv = (q == 0) ? 8 : 0; }
            else { int base, tf; bool rope;
                if (t < 2) { base = 0; tf = 0; rope = true; } else if (t < 4) { base = 512; tf = 2; rope = true; } else if (t < 6) { base = 1024; tf = 4; rope = false; }
                else if (t < 8) { base = 1536; tf = 6; rope = false; } else if (t < 10) { base = 2048; tf = 8; rope = false; } else if (t < 12) { base = 2560; tf = 10; rope = false; }
                else if (t < 15) { base = 3080; tf = 12; rope = true; } else if (t < 18) { base = 3848; tf = 15; rope = true; } else { base = 4616; tf = 18; rope = false; }
                c0 = base + (t - tf) * 256 + (rope ? ((q & 3) * 64 + (q >> 2) * 32) : 32 * q); }
            tr_item(a.w_in + (size_t)l * DM * IN_COLS, IN_COLS, kb * 64, c0, ncv, Wb + W_IN / 2, 1024, grp * 32, kb * 64, scr, lane); continue; }
        r -= N0;
        if (r < N1) { const int grp = r >> 4, kb = r & 15; tr_item(a.w_gate + (size_t)l * DM * 3072, 3072, kb * 64, grp * 32, 32, Wb + W_GATE / 2, 1024, grp * 32, kb * 64, scr, lane); continue; }
        r -= N1;
        if (r < 5 * N2) { const int which = r / N2, rr = r % N2, grp = rr >> 4, kb = rr & 15;
            const float* src = (which == 0 ? a.w_out : which == 1 ? a.w_xq : which == 2 ? a.w_xk : which == 3 ? a.w_xv : a.w_xo) + (size_t)l * DM * DM;
            const size_t dst = which == 0 ? W_OUT : which == 1 ? W_XQ : which == 2 ? W_XK : which == 3 ? W_XV : W_XO;
            tr_item(src, 1024, kb * 64, grp * 32, 32, Wb + dst / 2, 1024, grp * 32, kb * 64, scr, lane); continue; }
        r -= 5 * N2;
        if (r < 2 * N7) { const int which = r / N7, rr = r % N7, grp = rr >> 3, kb = rr & 7;
            tr_item((which ? a.w_branch_b : a.w_branch_a) + (size_t)l * 512 * DM, 1024, kb * 64, grp * 32, 32, Wb + (which ? W_BB : W_BA) / 2, 512, grp * 32, kb * 64, scr, lane); continue; }
        r -= 2 * N7;
        if (r < N9) { const int grp = r >> 2, kb = r & 3; tr_item(a.w_branch_c + (size_t)l * 256 * DM, 1024, kb * 64, grp * 32, 32, Wb + W_BC / 2, 256, grp * 32, kb * 64, scr, lane); continue; }
        r -= N9;
        if (r < N10) {
            const int kb = r & 15, q = (r >> 4) & 7, jh = (r >> 7) & 1, e = r >> 8;
            const float* src = ((q < 4) ? a.w_eg : a.w_eu) + ((size_t)l * 16 + e) * DM * 256;
            tr_item(src, 256, kb * 64, jh * 128 + 32 * (q & 3), 32, Wb + W_E1 / 2, 1024, (e * 2 + jh) * 256 + q * 32, kb * 64, scr, lane); continue; }
        r -= N10;
        {
            const int kb = r & 3, grp = (r >> 2) & 31, slot = (r >> 7) & 1, bk = r >> 8, g = bk / 6, pr = bk % 6;
            const int lo = pr < 3 ? 0 : (pr < 5 ? 1 : 2), hi = pr < 3 ? pr + 1 : (pr < 5 ? pr - 1 : 3);
            const int e = g * 4 + (slot ? hi : lo);
            tr_item(a.w_ed + ((size_t)l * 16 + e) * 256 * DM, 1024, kb * 64, grp * 32, 32, Wb + W_DP / 2 + (size_t)bk * 1024 * 512, 512, grp * 32, slot * 256 + kb * 64, scr, lane); }
    }
}

__device__ __forceinline__ void rows_to_bf16(const float* src, bf16_t* dst, int nrows, int gw, int NGW, int lane) {
    for (int m = gw; m < nrows; m += NGW) {
        const f32x4* xr = (const f32x4*)(src + (size_t)m * DM) + lane; u32x2* o8 = (u32x2*)(dst + (size_t)m * DM) + lane;
#pragma unroll
        for (int j = 0; j < 4; ++j) { const f32x4 v = xr[64 * j]; u32x2 w; w.x = pk2(v[0], v[1]); w.y = pk2(v[2], v[3]); o8[64 * j] = w; }
    }
}

template <bool ROUTE>
__device__ __forceinline__ void ln_phase(const Args& a, int l, int sub, int gw, int NGW, int lane) {
    const float* gam = a.ln_g + ((size_t)l * 3 + sub) * DM; const float* bet = a.ln_b + ((size_t)l * 3 + sub) * DM;
    bf16_t* xb = (bf16_t*)(a.ws + OFF_XB);
    unsigned* ctl = (unsigned*)(a.ws + OFF_CTL);
    for (int m = gw; m < T; m += NGW) {
        f32x4* xr = (f32x4*)(a.out + (size_t)m * DM) + lane;
        f32x4 v[4]; float s = 0.f;
#pragma unroll
        for (int j = 0; j < 4; ++j) { v[j] = xr[64 * j]; s += (v[j][0] + v[j][1]) + (v[j][2] + v[j][3]); }
        const float mean = wave_sum(s) * (1.f / DM); float s2 = 0.f;
#pragma unroll
        for (int j = 0; j < 4; ++j) { v[j] = v[j] - mean; s2 += (v[j][0] * v[j][0] + v[j][1] * v[j][1]) + (v[j][2] * v[j][2] + v[j][3] * v[j][3]); }
        const float rstd = 1.f / sqrtf(wave_sum(s2) * (1.f / DM) + LN_EPS);
        u32x2* o8 = (u32x2*)(xb + (size_t)m * DM) + lane;
#pragma unroll
        for (int j = 0; j < 4; ++j) { const f32x4 gg = *((const f32x4*)gam + lane + 64 * j), bb = *((const f32x4*)bet + lane + 64 * j);
            v[j] = v[j] * rstd * gg + bb; xr[64 * j] = v[j]; u32x2 w; w.x = pk2(v[j][0], v[j][1]); w.y = pk2(v[j][2], v[j][3]); o8[64 * j] = w; }
        if (ROUTE) {
            const f32x4* wrg = (const f32x4*)(a.w_rg + (size_t)l * DM * 4);
            f32x4 gl = {0.f, 0.f, 0.f, 0.f};
#pragma unroll
            for (int j = 0; j < 4; ++j)
#pragma unroll
                for (int i = 0; i < 4; ++i) gl += wrg[256 * j + 4 * lane + i] * v[j][i];
            float g4[4];
#pragma unroll
            for (int k = 0; k < 4; ++k) g4[k] = wave_sum(gl[k]) + a.b_rg[l * 4 + k];
            int gi = 0; float gm = g4[0];
#pragma unroll
            for (int k = 1; k < 4; ++k) if (g4[k] > gm) { gm = g4[k]; gi = k; }
            float gs = 0.f;
#pragma unroll
            for (int k = 0; k < 4; ++k) gs += __expf(g4[k] - gm);
            const float ggate = 1.f / gs;
            const f32x4* wre = (const f32x4*)(a.w_re + ((size_t)l * 4 + gi) * DM * 4);
            f32x4 el = {0.f, 0.f, 0.f, 0.f};
#pragma unroll
            for (int j = 0; j < 4; ++j)
#pragma unroll
                for (int i = 0; i < 4; ++i) el += wre[256 * j + 4 * lane + i] * v[j][i];
            float e4[4];
#pragma unroll
            for (int k = 0; k < 4; ++k) e4[k] = wave_sum(el[k]) + a.b_re[(l * 4 + gi) * 4 + k];
            int i1 = 0; float v1 = e4[0];
#pragma unroll
            for (int k = 1; k < 4; ++k) if (e4[k] > v1) { v1 = e4[k]; i1 = k; }
            int i2 = -1; float v2 = -INFINITY;
#pragma unroll
            for (int k = 0; k < 4; ++k) if (k != i1 && e4[k] > v2) { v2 = e4[k]; i2 = k; }
            const float w1 = 1.f / (1.f + __expf(v2 - v1)), w2 = 1.f - w1;
            const int lo = i1 < i2 ? i1 : i2, hi = i1 < i2 ? i2 : i1;
            const float wlo = (i1 < i2 ? w1 : w2) * ggate, whi = (i1 < i2 ? w2 : w1) * ggate;
            const int pr = lo == 0 ? hi - 1 : (lo == 1 ? hi + 1 : 5);
            const int bk = gi * 6 + pr;
            if (lane == 0) { u32x4 ti; ti.x = (unsigned)bk; ti.y = __float_as_uint(wlo); ti.z = __float_as_uint(whi); ti.w = 0u;
                *(u32x4*)(a.ws + OFF_TOKINFO + (size_t)m * 16) = ti;
                __hip_atomic_fetch_add(ctl + CW_CNT + l * 32 + bk, 1u, __ATOMIC_RELAXED, __HIP_MEMORY_SCOPE_AGENT); }
        }
    }
}

__device__ __forceinline__ void moe_tables(const Args& a, int l, LAS int* tb) {
    unsigned* ctl = (unsigned*)(a.ws + OFF_CTL);
    if (threadIdx.x == 0) {
        int start = 0;
#pragma clang loop unroll(disable)
        for (int b = 0; b < NBUCKET; ++b) { const int c = (int)__hip_atomic_load(ctl + CW_CNT + l * 32 + b, __ATOMIC_RELAXED, __HIP_MEMORY_SCOPE_AGENT);
            tb[b] = start; const int nt = (c + 255) >> 8;
#pragma clang loop unroll(disable)
            for (int t = 0; t < nt; ++t) tb[64 + (start >> 8) + t] = b;
            start += nt << 8; }
        tb[32] = start >> 8;
    }
    __syncthreads();
}

struct MoeOrder {
    const LAS int* tb; const char* A; const char* B; size_t astep; int mode, G, c;
    __device__ __forceinline__ bool next(int i, pg8::Unit& u) const {
        const int L = i * G + c, nrt = tb[32]; if (L >= nrt * 4) return false;
        const int rt = L >> 2, pn = L & 3, bk = tb[64 + rt];
        u.pm = rt; u.pn = pn; u.A = A + (size_t)rt * astep;
        if (mode == 0) { const int g = bk / 6, pr = bk % 6, lo = pr < 3 ? 0 : (pr < 5 ? 1 : 2), hi = pr < 3 ? pr + 1 : (pr < 5 ? pr - 1 : 3);
            const int e = g * 4 + ((pn >> 1) ? hi : lo); u.B = B + ((size_t)(e * 2 + (pn & 1)) * 256) * 1024 * 2; }
        else u.B = B + ((size_t)bk * 1024 + (size_t)pn * 256) * 512 * 2;
        return true;
    }
};

#ifndef PH_MASK
#define PH_MASK 0xFFFFFF
#endif
__global__ void __launch_bounds__(512, 2) fwd_kernel(Args a) {
    extern __shared__ __attribute__((aligned(16))) unsigned char lds_raw[];
    LAS unsigned char* lds = (LAS unsigned char*)lds_raw;
    volatile LAS unsigned* MISC = (volatile LAS unsigned*)(lds + MISC_OFF);
    for (int u = threadIdx.x; u < (LDS_BYTES - MISC_OFF) / 4; u += 512) ((LAS unsigned*)(lds + MISC_OFF))[u] = 0u;
    __syncthreads();
    XcdBarrier bar = xcd_barrier_post((unsigned*)(a.ws + OFF_CTL) + CW_BAR, MISC + 8);
    LAS int* tb = (LAS int*)(lds + MISC_OFF + 1024);
#define PHASE_VARS \
    size_t z_l = 0; asm volatile("" : "+s"(z_l)); unsigned char* ws = a.ws + z_l; \
    int bx = blockIdx.x; asm volatile("" : "+s"(bx)); \
    int tid = threadIdx.x; asm volatile("" : "+v"(tid)); \
    int G = gridDim.x; asm volatile("" : "+s"(G)); \
    const int lane = tid & 63, wave = __builtin_amdgcn_readfirstlane(tid >> 6), gw = bx * 8 + wave, NGW = G * 8; \
    unsigned* ctl = (unsigned*)(ws + OFF_CTL); bf16_t* xb = (bf16_t*)(ws + OFF_XB); bf16_t* Wb = (bf16_t*)(ws + OFF_W); \
    float* cosT = (float*)(ws + OFF_COS); float* sinT = (float*)(ws + OFF_SIN); float* logf_ = (float*)(ws + OFF_LOGF); float* kbias = (float*)(ws + OFF_KBIAS); float* lse = (float*)(ws + OFF_LSE); \
    (void)lane; (void)wave; (void)gw; (void)NGW; (void)ctl; (void)xb; (void)Wb; (void)cosT; (void)sinT; (void)logf_; (void)kbias; (void)lse; (void)tid;

    { PHASE_VARS
    rows_to_bf16(a.x, xb, T, gw, NGW, lane);
    rows_to_bf16(a.mem, (bf16_t*)(ws + OFF_MEMB), NB * MEMLEN, gw, NGW, lane);
    for (int i = bx * 512 + tid; i < T * 32; i += G * 512) { const int tok = i >> 5, d = i & 31;
        const double inv = exp2(-(double)d * (13.287712379549449 / 32.0));
        const double rev = (double)a.positions[tok] * inv * 0.15915494309189535; const float fr = (float)(rev - floor(rev));
        cosT[i] = __builtin_amdgcn_cosf(fr); sinT[i] = __builtin_amdgcn_sinf(fr); }
    }

    for (int l = 0; l < 2; ++l) {
        const float lam_init = (l == 0) ? 0.2f : 0.35550906759f;
#if (PH_MASK >> 0) & 1
        { PHASE_VARS
        convert_layer(a, l, lds, gw, NGW, wave, lane);
        for (int i = bx * 512 + tid; i < MAXRT * 256; i += G * 512) ((int*)(ws + OFF_ROWTOK))[i] = -1;
        xcd_barrier(bar);

        }
#endif
#if (PH_MASK >> 1) & 1
        { PHASE_VARS
        { pg8::GridOrder S; S.init(xb, 1024, Wb + W_IN / 2, 1024, T, NPROJ, G, bx);
          pg8::EpiProj E{ws, cosT, sinT, a.b_forget + l * 8, logf_};
          pg8::gemm_phase(lds, pg8::Gemm{1024, 1024, 1024}, S, E); }
        { pg8::GridOrder S; S.init(ws + OFF_MEMB, 1024, Wb + W_XK / 2, 1024, NB * MEMLEN, DM, G, bx);
          pg8::EpiStore E{(bf16_t*)(ws + OFF_KX), 1024, nullptr, 1.f, 0};
          pg8::gemm_phase(lds, pg8::Gemm{1024, 1024, 1024}, S, E); }
        { pg8::GridOrder S; S.init(ws + OFF_MEMB, 1024, Wb + W_XV / 2, 1024, NB * MEMLEN, DM, G, (bx + 128) % G);
          pg8::EpiStore E{(bf16_t*)(ws + OFF_VX), 1024, nullptr, 1.f, 0};
          pg8::gemm_phase(lds, pg8::Gemm{1024, 1024, 1024}, S, E); }
        xcd_barrier(bar);

        }
#endif
#if (PH_MASK >> 2) & 1
        { PHASE_VARS
        if (gw < 64) {
            const int b = gw >> 3, h = gw & 7; const float* src = logf_ + ((size_t)b * SEQ + lane * 64) * 8 + h;
            float run = 0.f;
            for (int i = 0; i < 64; ++i) run += src[(size_t)i * 8];
            float incl = run;
#pragma unroll
            for (int o = 1; o < 64; o <<= 1) { const float t = __shfl_up(incl, o); if (lane >= o) incl += t; }
            float c = incl - run; float* dst = kbias + ((size_t)b * 8 + h) * SEQ + lane * 64;
            for (int i = 0; i < 64; ++i) { c += src[(size_t)i * 8]; dst[i] = -c * LOG2E; }
        }
        for (int L = bx; L < 1536; L += G) {
            const int bs = L / 48, r = L % 48, grp = r >> 4, sub = r & 15, b = bs >> 2, slot = bs & 3;
            const int dil = grp == 0 ? 1 : (grp == 1 ? 4 : 16), nblk = 16 / dil, cls = sub / nblk, blk = sub % nblk;
            const size_t base = ((size_t)b * SEQ + cls) * 768 + grp * 256 + slot * 64;
            fa::Prm p; p.Q = (const bf16_t*)(ws + P_QC) + base; p.K = (const bf16_t*)(ws + P_KC) + base; p.V = (const bf16_t*)(ws + P_VC) + base;
            p.qld = p.kld = p.vld = 768; p.rs = dil; p.q0 = blk * 256; p.kt0 = blk * 4 - 2 < 0 ? 0 : blk * 4 - 2; p.kt1 = blk * 4 + 4; p.causal = 1; p.win = 128; p.kbias = nullptr;
            f32x16 o[2]; float m, lsum;
            fa::pass<64, 64, false>(lds, p, o, m, lsum);
            const float lt = fa::normalise<2>(lds, o, lsum);
            fa::store_o<2>(o, (bf16_t*)(ws + P_QC) + base, 768, dil, p.q0);
            if (lane < 32) { const int qi = p.q0 + wave * 32 + lane; lse[((size_t)b * SEQ + cls + (size_t)qi * dil) * 12 + grp * 4 + slot] = (m + __log2f(lt)) * LN2; }
        }
        xcd_barrier(bar);

        }
#endif
#if (PH_MASK >> 3) & 1
        { PHASE_VARS
        for (int i = bx * 512 + tid; i < T * 32; i += G * 512) {
            const int tok = i >> 5, slot = (i >> 3) & 3, ch = i & 7;
            const float l0 = lse[(size_t)tok * 12 + slot], l1 = lse[(size_t)tok * 12 + 4 + slot], l2 = lse[(size_t)tok * 12 + 8 + slot];
            const float mx = fmaxf(l0, fmaxf(l1, l2)); float w0 = __expf(l0 - mx), w1 = __expf(l1 - mx), w2 = __expf(l2 - mx); const float inv = 1.f / (w0 + w1 + w2); w0 *= inv; w1 *= inv; w2 *= inv;
            const bf16_t* src = (const bf16_t*)(ws + P_QC) + (size_t)tok * 768 + slot * 64 + ch * 8;
            const u32x4 a0 = *(const u32x4*)src, a1 = *(const u32x4*)(src + 256), a2 = *(const u32x4*)(src + 512); u32x4 o;
#pragma unroll
            for (int k = 0; k < 4; ++k) {
                const float lo = w0 * __uint_as_float(a0[k] << 16) + w1 * __uint_as_float(a1[k] << 16) + w2 * __uint_as_float(a2[k] << 16);
                const float hi = w0 * __uint_as_float(a0[k] & 0xffff0000u) + w1 * __uint_as_float(a1[k] & 0xffff0000u) + w2 * __uint_as_float(a2[k] & 0xffff0000u);
                o[k] = pk2(lo, hi); }
            *(u32x4*)((bf16_t*)(ws + P_OC) + (size_t)tok * 256 + slot * 64 + ch * 8) = o;
        }
        {
            float lam;
            { const float* dl = a.diff_lambda + (size_t)l * 256; float d1 = 0.f, d2 = 0.f;
              for (int i = 0; i < 64; ++i) { d1 += dl[i] * dl[64 + i]; d2 += dl[128 + i] * dl[192 + i]; }
              lam = expf(d1) - expf(d2) + lam_init; }
            for (int i = 0; ; ++i) {
                const int L = (i & 1) ? i * G + (G - 1 - bx) : i * G + bx; if (L >= 1536) break;
                const int lvl = L / 96, idx = L % 96, qb = 15 - lvl;
                if (idx < 32) {
                    const int b = idx >> 2, h = idx & 3; const size_t base = (size_t)b * SEQ * 512 + h * 128;
                    fa::Prm p; p.Q = (const bf16_t*)(ws + P_QA) + base; p.K = (const bf16_t*)(ws + P_KA) + base; p.V = (const bf16_t*)(ws + P_VA) + base;
                    p.qld = p.kld = p.vld = 512; p.rs = 1; p.q0 = qb * 256; p.kt0 = 0; p.kt1 = qb * 4 + 4; p.causal = 1; p.win = 1 << 30; p.kbias = nullptr;
                    f32x16 o1[4], o2[4]; float m, lsum;
                    fa::pass<64, 128, false>(lds, p, o1, m, lsum);
                    fa::normalise<4>(lds, o1, lsum);
                    f32x4* stash = (f32x4*)(ws + P_KC + (size_t)bx * 131072 + (size_t)(wave * 64 + lane) * 256);
#pragma unroll
                    for (int db = 0; db < 4; ++db)
#pragma unroll
                        for (int q = 0; q < 4; ++q) stash[db * 4 + q] = (f32x4){o1[db][4 * q], o1[db][4 * q + 1], o1[db][4 * q + 2], o1[db][4 * q + 3]};
                    asm volatile("" ::: "memory");
                    p.Q += 64; p.K += 64;
                    fa::pass<64, 128, false>(lds, p, o2, m, lsum);
                    fa::normalise<4>(lds, o2, lsum);
#pragma unroll
                    for (int db = 0; db < 4; ++db)
#pragma unroll
                        for (int q = 0; q < 4; ++q) { const f32x4 t = stash[db * 4 + q]; o1[db][4 * q] = t[0]; o1[db][4 * q + 1] = t[1]; o1[db][4 * q + 2] = t[2]; o1[db][4 * q + 3] = t[3]; }
                    const float* sg = a.diff_subln + (size_t)l * 128;
#pragma unroll
                    for (int r = 0; r < 16; ++r) { float ss = 0.f;
#pragma unroll
                        for (int db = 0; db < 4; ++db) { const float d = o1[db][r] - lam * o2[db][r]; o1[db][r] = d; ss += d * d; }
#pragma unroll
                        for (int s = 1; s < 32; s <<= 1) ss += __shfl_xor(ss, s);
                        const float rn = 1.f / sqrtf(ss * (1.f / 128.f) + LN_EPS) * (1.f - lam_init);
#pragma unroll
                        for (int db = 0; db < 4; ++db) o1[db][r] *= rn * sg[db * 32 + (lane & 31)]; }
                    fa::store_o<4>(o1, (bf16_t*)(ws + P_QA) + base, 512, 1, p.q0);
                } else {
                    const int bh = idx - 32, b = bh >> 3, h = bh & 7; const size_t base = (size_t)b * SEQ * 512 + h * 64;
                    fa::Prm p; p.Q = (const bf16_t*)(ws + P_QB) + base; p.K = (const bf16_t*)(ws + P_KB) + base; p.V = (const bf16_t*)(ws + P_VB) + base;
                    p.qld = p.kld = p.vld = 512; p.rs = 1; p.q0 = qb * 256; p.kt0 = 0; p.kt1 = qb * 4 + 4; p.causal = 1; p.win = 1 << 30; p.kbias = kbias + (size_t)bh * SEQ;
                    f32x16 o[2]; float m, lsum;
                    fa::pass<64, 64, true>(lds, p, o, m, lsum);
                    fa::normalise<2>(lds, o, lsum);
                    fa::store_o<2>(o, (bf16_t*)(ws + P_QB) + base, 512, 1, p.q0);
                }
            }
        }
        xcd_barrier(bar);

        }
#endif
#if (PH_MASK >> 4) & 1
        { PHASE_VARS
        { pg8::GridOrder S; S.init(xb, 1024, Wb + W_GATE / 2, 1024, T, 3072, G, bx);
          pg8::EpiStore E{(bf16_t*)(ws + P_G), 3072, a.b_gate + (size_t)l * 3072, 1.f, 1};
          pg8::gemm_phase(lds, pg8::Gemm{1024, 1024, 1024}, S, E); }
        xcd_barrier(bar);

        }
#endif
#if (PH_MASK >> 5) & 1
        { PHASE_VARS
        { pg8::GridOrder S; S.init(ws + P_QA, 512, Wb + W_BA / 2, 512, T, DM, G, bx);
          pg8::EpiGate E{(bf16_t*)(ws + P_G), 0}; pg8::gemm_phase(lds, pg8::Gemm{512, 512, 512}, S, E); }
        __syncthreads();
        { pg8::GridOrder S; S.init(ws + P_QB, 512, Wb + W_BB / 2, 512, T, DM, G, bx);
          pg8::EpiGate E{(bf16_t*)(ws + P_G), 1}; pg8::gemm_phase(lds, pg8::Gemm{512, 512, 512}, S, E); }
        __syncthreads();
        { pg8::GridOrder S; S.init(ws + P_OC, 256, Wb + W_BC / 2, 256, T, DM, G, bx);
          pg8::EpiGate E{(bf16_t*)(ws + P_G), 2}; pg8::gemm_phase(lds, pg8::Gemm{256, 256, 256}, S, E); }
        xcd_barrier(bar);

        }
#endif
#if (PH_MASK >> 6) & 1
        { PHASE_VARS
        { pg8::GridOrder S; S.init(ws + P_G, 3072, Wb + W_OUT / 2, 1024, T, DM, G, bx);
          pg8::EpiResid E{l == 0 ? a.x : a.out, a.out, nullptr}; pg8::gemm_phase(lds, pg8::Gemm{3072, 1024, 1024}, S, E); }
        xcd_barrier(bar);
        ln_phase<false>(a, l, 0, gw, NGW, lane);
        xcd_barrier(bar);

        }
#endif
#if (PH_MASK >> 7) & 1
        { PHASE_VARS
        { pg8::GridOrder S; S.init(xb, 1024, Wb + W_XQ / 2, 1024, T, DM, G, bx);
          pg8::EpiStore E{(bf16_t*)(ws + P_XQ), 1024, nullptr, XSCALE, 0}; pg8::gemm_phase(lds, pg8::Gemm{1024, 1024, 1024}, S, E); }
        xcd_barrier(bar);

        }
#endif
#if (PH_MASK >> 8) & 1
        { PHASE_VARS
        for (int L = bx; L < 1024; L += G) {
            const int qb = L & 15, vh = (L >> 4) & 1, h = (L >> 5) & 3, b = L >> 7;
            fa::Prm p; p.Q = (const bf16_t*)(ws + P_XQ) + (size_t)b * SEQ * 1024 + h * 256; p.K = (const bf16_t*)(ws + OFF_KX) + (size_t)b * MEMLEN * 1024 + h * 256;
            p.V = (const bf16_t*)(ws + OFF_VX) + (size_t)b * MEMLEN * 1024 + h * 256 + vh * 128;
            p.qld = p.kld = p.vld = 1024; p.rs = 1; p.q0 = qb * 256; p.kt0 = 0; p.kt1 = 4; p.causal = 0; p.win = 1 << 30; p.kbias = nullptr;
            f32x16 o[4]; float m, lsum;
            fa::pass<256, 128, false, false>(lds, p, o, m, lsum);
            fa::normalise<4>(lds, o, lsum);
            fa::store_o<4>(o, (bf16_t*)(ws + P_XO) + (size_t)b * SEQ * 1024 + h * 256 + vh * 128, 1024, 1, p.q0);
        }
        xcd_barrier(bar);

        }
#endif
#if (PH_MASK >> 9) & 1
        { PHASE_VARS
        { pg8::GridOrder S; S.init(ws + P_XO, 1024, Wb + W_XO / 2, 1024, T, DM, G, bx);
          pg8::EpiResid E{a.out, a.out, nullptr}; pg8::gemm_phase(lds, pg8::Gemm{1024, 1024, 1024}, S, E); }
        xcd_barrier(bar);
        ln_phase<true>(a, l, 1, gw, NGW, lane);
        xcd_barrier(bar);

        }
#endif
#if (PH_MASK >> 10) & 1
        { PHASE_VARS
        moe_tables(a, l, tb);
        for (int m = gw; m < T; m += NGW) {
            const u32x4 ti = *(const u32x4*)(ws + OFF_TOKINFO + (size_t)m * 16);
            int pos = 0;
            if (lane == 0) pos = tb[ti.x] + (int)__hip_atomic_fetch_add(ctl + CW_CUR + l * 32 + ti.x, 1u, __ATOMIC_RELAXED, __HIP_MEMORY_SCOPE_AGENT);
            pos = __shfl(pos, 0);
            if (lane == 0) { ((int*)(ws + OFF_ROWTOK))[pos] = m; f32x2 w = {__uint_as_float(ti.y), __uint_as_float(ti.z)}; *(f32x2*)(ws + OFF_ROWW + (size_t)pos * 8) = w; }
            const u32x4* src = (const u32x4*)(xb + (size_t)m * DM); u32x4* dst = (u32x4*)((bf16_t*)(ws + P_XG) + (size_t)pos * DM);
            dst[lane] = src[lane]; dst[64 + lane] = src[64 + lane];
        }
        xcd_barrier(bar);

        }
#endif
#if (PH_MASK >> 11) & 1
        { PHASE_VARS
        { MoeOrder S{tb, (const char*)(ws + P_XG), (const char*)(Wb + W_E1 / 2), (size_t)256 * 1024 * 2, 0, G, bx};
          pg8::EpiSwiglu E{(bf16_t*)(ws + P_H), (const float*)(ws + OFF_ROWW)}; pg8::gemm_phase(lds, pg8::Gemm{1024, 1024, 1024}, S, E); }
        xcd_barrier(bar);

        }
#endif
#if (PH_MASK >> 12) & 1
        { PHASE_VARS
        { MoeOrder S{tb, (const char*)(ws + P_H), (const char*)(Wb + W_DP / 2), (size_t)256 * 512 * 2, 1, G, bx};
          pg8::EpiResid E{a.out, a.out, (const int*)(ws + OFF_ROWTOK)}; pg8::gemm_phase(lds, pg8::Gemm{512, 512, 512}, S, E); }
        xcd_barrier(bar);
        ln_phase<false>(a, l, 2, gw, NGW, lane);
        xcd_barrier(bar);
        }
#endif
    }
}

extern "C" void kernel_launch(void* const* d_in, const int* in_sizes, int n_in, void* d_out, int out_size, void* d_ws, size_t ws_size, hipStream_t stream) {
    static int grid = 0;
    if (grid == 0) {
        if (n_in != 26 || ws_size < WS_NEED) { grid = -1; return; }
        int dev = 0, cus = 0;
        if (hipGetDevice(&dev) != hipSuccess || hipDeviceGetAttribute(&cus, hipDeviceAttributeMultiprocessorCount, dev) != hipSuccess) { grid = -1; return; }
        if (hipFuncSetAttribute((const void*)fwd_kernel, hipFuncAttributeMaxDynamicSharedMemorySize, LDS_BYTES) != hipSuccess) { grid = -1; return; }
        int per_cu = 0;
        (void)hipOccupancyMaxActiveBlocksPerMultiprocessor(&per_cu, (const void*)fwd_kernel, 512, LDS_BYTES);
        (void)hipGetLastError();
        grid = cus;
    }
    if (grid < 0) return;
    (void)hipMemsetAsync((char*)d_ws + OFF_CTL, 0, CTL_BYTES, stream);
    Args a{};
    a.x = (const float*)d_in[0]; a.mem = (const float*)d_in[1]; a.positions = (const int*)d_in[2];
    a.w_in = (const float*)d_in[3]; a.b_forget = (const float*)d_in[4]; a.diff_lambda = (const float*)d_in[5]; a.diff_subln = (const float*)d_in[6];
    a.w_branch_a = (const float*)d_in[7]; a.w_branch_b = (const float*)d_in[8]; a.w_branch_c = (const float*)d_in[9]; a.w_gate = (const float*)d_in[10]; a.b_gate = (const float*)d_in[11];
    a.w_out = (const float*)d_in[12]; a.w_xq = (const float*)d_in[13]; a.w_xk = (const float*)d_in[14]; a.w_xv = (const float*)d_in[15]; a.w_xo = (const float*)d_in[16];
    a.w_rg = (const float*)d_in[17]; a.b_rg = (const float*)d_in[18]; a.w_re = (const float*)d_in[19]; a.b_re = (const float*)d_in[20];
    a.w_eg = (const float*)d_in[21]; a.w_eu = (const float*)d_in[22]; a.w_ed = (const float*)d_in[23]; a.ln_g = (const float*)d_in[24]; a.ln_b = (const float*)d_in[25];
    a.out = (float*)d_out; a.ws = (unsigned char*)d_ws;
    hipLaunchKernelGGL(fwd_kernel, dim3(grid), dim3(512), LDS_BYTES, stream, a);
}
```

```cpp
#include <hip/hip_runtime.h>
#include <stdint.h>
#include <math.h>

#define LAS __attribute__((address_space(3)))
#define GAS __attribute__((address_space(1)))
typedef unsigned short bf16_t;
typedef short bf16x8 __attribute__((ext_vector_type(8)));
typedef short s16x4 __attribute__((ext_vector_type(4)));
typedef float f32x2 __attribute__((ext_vector_type(2)));
typedef float f32x4 __attribute__((ext_vector_type(4)));
typedef float f32x16 __attribute__((ext_vector_type(16)));
typedef unsigned u32x2 __attribute__((ext_vector_type(2)));
typedef unsigned u32x4 __attribute__((ext_vector_type(4)));
typedef __bf16 bf16x2_t __attribute__((ext_vector_type(2)));

constexpr int NB = 8, SEQ = 4096, DM = 1024, T = NB * SEQ, MEMLEN = 256;
constexpr int IN_COLS = 5384, NPROJ = 5632;
constexpr float LOG2E = 1.4426950408889634f, LN2 = 0.6931471805599453f;
constexpr float DN_ALPHA = 1.4142135623730951f;
constexpr float LN_EPS = 1e-5f;
constexpr float QSCALE = 0.125f * LOG2E;
constexpr float XSCALE = 0.0625f * LOG2E;
constexpr int NBUCKET = 24, MAXRT = 152;

constexpr size_t MiB = 1u << 20;
constexpr size_t OFF_CTL = 0, CTL_BYTES = 1 * MiB;
constexpr size_t OFF_COS = 1 * MiB, OFF_SIN = 5 * MiB;
constexpr size_t OFF_LOGF = 9 * MiB;
constexpr size_t OFF_KBIAS = 10 * MiB;
constexpr size_t OFF_LSE = 11 * MiB;
constexpr size_t OFF_RGT = 12 * MiB + 512 * 1024;
constexpr size_t OFF_ROWTOK = 13 * MiB;
constexpr size_t OFF_ROWW = 13 * MiB + 256 * 1024;
constexpr size_t OFF_TOKINFO = 14 * MiB;
constexpr size_t OFF_KX = 15 * MiB, OFF_VX = 19 * MiB;
constexpr size_t OFF_MEMB = 23 * MiB;
constexpr size_t OFF_W = 27 * MiB;
constexpr size_t W_IN = 0, W_GATE = W_IN + (size_t)NPROJ * 1024 * 2, W_OUT = W_GATE + 6 * MiB, W_BA = W_OUT + 2 * MiB, W_BB = W_BA + 1 * MiB,
                 W_BC = W_BB + 1 * MiB, W_XQ = W_BC + MiB / 2, W_XK = W_XQ + 2 * MiB, W_XV = W_XK + 2 * MiB, W_XO = W_XV + 2 * MiB,
                 W_E1 = W_XO + 2 * MiB, W_DP = W_E1 + 16 * MiB, W_END = W_DP + 24 * MiB;
static_assert(W_END <= 70 * MiB, "weights");
constexpr size_t OFF_XB = 97 * MiB;
constexpr size_t OFF_PROJ = 161 * MiB;
constexpr size_t P_QA = OFF_PROJ, P_QB = P_QA + 32 * MiB, P_QC = P_QB + 32 * MiB, P_KA = P_QC + 48 * MiB, P_VA = P_KA + 32 * MiB,
                 P_KB = P_VA + 32 * MiB, P_VB = P_KB + 32 * MiB, P_KC = P_VB + 32 * MiB, P_VC = P_KC + 48 * MiB, P_END = P_VC + 48 * MiB;
static_assert(P_END == 497 * MiB, "proj map");
constexpr size_t P_OC = P_END - 16 * MiB;
constexpr size_t P_G = P_KA;
static_assert(P_G + (size_t)T * 3072 * 2 <= P_OC, "G overlay");
constexpr size_t P_XQ = OFF_PROJ, P_XO = OFF_PROJ + 64 * MiB;
constexpr size_t P_XG = OFF_PROJ, P_H = OFF_PROJ + 80 * MiB;
constexpr size_t WS_NEED = P_END;
constexpr int CW_BAR = 4096;
constexpr int CW_CNT = 16384;
#ifndef PRE_K
#define PRE_K 0
#endif
constexpr int CW_CUR = 16384 + 128;

constexpr int RING_BYTES = 131072;
constexpr int MISC_OFF = RING_BYTES;
constexpr int LDS_BYTES = 147456;
constexpr int FA_SCR_OFF = 122880;

__device__ __forceinline__ unsigned pk2(float lo, float hi) { f32x2 v = {lo, hi}; bf16x2_t b = __builtin_convertvector(v, bf16x2_t); return __builtin_bit_cast(unsigned, b); }
__device__ __forceinline__ float bf2f(unsigned short h) { return __uint_as_float(((unsigned)h) << 16); }
__device__ __forceinline__ float wave_sum(float v) {
#pragma unroll
    for (int o = 1; o < 64; o <<= 1) v += __shfl_xor(v, o);
    return v;
}
#define LDS_WAIT() asm volatile("s_waitcnt lgkmcnt(0)" ::: "memory")

#define XB_TMO      128
#define XB_XCNT(j)  (256  + 64 * (j))
#define XB_XSUB(j)  (1280 + 64 * (j))
#define XB_XGEN(j)  (2304 + 64 * (j))
#define XB_TOP      3328
#define XB_TOPGEN   3392
#define XCD_BAR_WORDS 3456
#define XB_SPIN_CAP (1u << 18)
__device__ __forceinline__ unsigned xb_ld(unsigned* p)              { return __hip_atomic_load(p, __ATOMIC_RELAXED, __HIP_MEMORY_SCOPE_AGENT); }
__device__ __forceinline__ unsigned xb_add(unsigned* p, unsigned v) { return __hip_atomic_fetch_add(p, v, __ATOMIC_RELAXED, __HIP_MEMORY_SCOPE_AGENT); }
__device__ __forceinline__ unsigned xb_xcc_id() { return (unsigned)__builtin_amdgcn_s_getreg((3 << 11) | 20) & 0xFu; }
#define XB_SPIN(cond, bar) do { unsigned _sp = 0; while (cond) { __builtin_amdgcn_s_sleep(1); \
    if ((++_sp & 255u) == 0u) { if (xb_ld(&(bar)[XB_TMO])) break; if (_sp > XB_SPIN_CAP) { atomicAdd(&(bar)[XB_TMO], 1u); break; } } } } while (0)
struct XcdBarrier { unsigned* bar; unsigned x; volatile LAS unsigned* st; };
__device__ __forceinline__ XcdBarrier xcd_barrier_post(unsigned* bar, volatile LAS unsigned* st) {
    XcdBarrier b; b.bar = bar; b.x = xb_xcc_id(); b.st = st;
    if (threadIdx.x == 0) (void)xb_add(&bar[XB_XCNT(b.x)], 1u);
    return b;
}
__device__ __forceinline__ void xcd_barrier_complete(unsigned* bar, unsigned x, unsigned& nloc, unsigned& nx) {
    const unsigned G = gridDim.x * gridDim.y * gridDim.z;
    unsigned sum, cnt, mine, sp = 0u;
    for (;;) {
        sum = 0u; cnt = 0u; mine = 0u;
#pragma unroll
        for (unsigned j = 0; j < 16; ++j) { const unsigned c = xb_ld(&bar[XB_XCNT(j)]); sum += c; cnt += (c > 0u) ? 1u : 0u; mine = (j == x) ? c : mine; }
        if (sum == G) break;
        __builtin_amdgcn_s_sleep(1);
        if ((++sp & 255u) == 0u) { if (xb_ld(&bar[XB_TMO])) break; if (sp > XB_SPIN_CAP) { atomicAdd(&bar[XB_TMO], 1u); break; } }
    }
    nloc = mine > 0u ? mine : 1u; nx = cnt > 0u ? cnt : 1u;
}
__device__ __forceinline__ void xcd_barrier(const XcdBarrier& b) {
    asm volatile("s_waitcnt vmcnt(0)" ::: "memory");
    __syncthreads();
    if (threadIdx.x == 0) {
        unsigned* bar = b.bar;
        __builtin_amdgcn_s_waitcnt(0);
        unsigned nloc = b.st[0], nx = b.st[1];
        if (nloc == 0u) { xcd_barrier_complete(bar, b.x, nloc, nx); b.st[0] = nloc; b.st[1] = nx; }
        const unsigned old = xb_add(&bar[XB_XSUB(b.x)], 1u);
        const unsigned gen = old / nloc;
        if (old + 1u == (gen + 1u) * nloc) {
            __builtin_amdgcn_fence(__ATOMIC_RELEASE, "agent");
            asm volatile("s_waitcnt vmcnt(0)" ::: "memory");
            const unsigned og = xb_add(&bar[XB_TOP], 1u);
            const unsigned tg = og / nx;
            if (og + 1u == (tg + 1u) * nx) xb_add(&bar[XB_TOPGEN], 1u);
            else XB_SPIN(xb_ld(&bar[XB_TOPGEN]) == tg, bar);
            __builtin_amdgcn_fence(__ATOMIC_ACQUIRE, "agent");
            xb_add(&bar[XB_XGEN(b.x)], 1u);
            asm volatile("s_waitcnt vmcnt(0)" ::: "memory");
        } else {
            XB_SPIN(xb_ld(&bar[XB_XGEN(b.x)]) == gen, bar);
            __builtin_amdgcn_fence(__ATOMIC_ACQUIRE, "agent");
            asm volatile("s_waitcnt vmcnt(0)" ::: "memory");
        }
    }
    __syncthreads();
}

namespace pg8 {
constexpr int BM = 256, BK = 64, HALF = 128, HTB = HALF * BK * 2, STAGE_BYTES = 8 * HTB, NXCD = 8, WGM = 8;
__host__ __device__ __forceinline__ int lds_byte(int r, int c) { const int st = (r >> 4) * 2 + (c >> 5), rr = r & 15, cc = c & 31, ob = rr * 64 + cc * 2; return st * 1024 + (ob ^ (((ob >> 9) & 1) << 5)); }
__host__ __device__ __forceinline__ void stage_rc(int b, int& R, int& C) { const int st = b / 1024, sb = b % 1024, swz = sb ^ (((sb >> 9) & 1) << 5); R = (st >> 1) * 16 + swz / 64; C = (st & 1) * 32 + (swz % 64) / 2; }
__host__ __device__ __forceinline__ int perm32(int rho) { const int n = rho >> 4, i = rho & 15; return 8 * (i >> 2) + 4 * n + (i & 3); }

struct Unit { int pm, pn; const char* A; const char* B; };
struct Gemm { int lda, ldb, K; };

struct GridOrder {
    const char* A; const char* Bt; size_t astep, bstep; int nM, nN, nwg, G, c;
    __device__ __forceinline__ void init(const void* A_, int lda, const void* Bt_, int ldb, int M, int N, int G_, int c_) {
        A = (const char*)A_; Bt = (const char*)Bt_; astep = (size_t)BM * lda * 2; bstep = (size_t)BM * ldb * 2; nM = M / BM; nN = N / BM; nwg = nM * nN; G = G_; c = c_; }
    __device__ __forceinline__ bool next(int i, Unit& u) const {
        const long L = (long)i * G + c; if (L >= nwg) return false;
        int wgid = (int)L; { const int q = nwg / NXCD, r = nwg % NXCD, xcd = wgid % NXCD, off = wgid / NXCD; wgid = (xcd < r ? xcd * (q + 1) : r * (q + 1) + (xcd - r) * q) + off; }
        const int nig = WGM * nN, gid = wgid / nig, fm = gid * WGM, gsz = (nM - fm) < WGM ? (nM - fm) : WGM;
        u.pm = fm + ((wgid % nig) % gsz); u.pn = (wgid % nig) / gsz; u.A = A + (size_t)u.pm * astep; u.B = Bt + (size_t)u.pn * bstep; return true;
    }
};

__device__ __forceinline__ unsigned cvt_pk_bf16(float lo, float hi) { return pk2(lo, hi); }

template <class Epi, class Sched>
__device__ __forceinline__ void gemm_phase(LAS unsigned char* lds, const Gemm g, const Sched& S, const Epi& E) {
    int tid = threadIdx.x; asm volatile("" : "+v"(tid));
    const int wid = __builtin_amdgcn_readfirstlane(tid >> 6), lane = tid & 63, wr = wid >> 2, wc = wid & 3, fr = lane & 15, fq = lane >> 4;
    const int K = g.K, nt = K / BK;
    unsigned voffA[2], voffB[2];
#pragma unroll
    for (int i = 0; i < 2; ++i) { int R, C; stage_rc(tid * 16 + i * 8192, R, C); const int Rb = (R & ~31) + perm32(R & 31);
        voffA[i] = (unsigned)(R * g.lda + C) * 2u; voffB[i] = (unsigned)(Rb * g.ldb + C) * 2u; }
    const size_t kstep = (size_t)(BK * 2);
    const size_t hstepA = (size_t)HALF * g.lda * 2, hstepB = (size_t)HALF * g.ldb * 2;
    const unsigned ldsw = (unsigned)wid * 1024u;
    const int aoff = lds_byte(wr * 64 + fr, fq * 8), boff = lds_byte(wc * 32 + fr, fq * 8);
#define PG8_SA(b, h) (((b) * 2 + (h)) * HTB)
#define PG8_SB(b, h) ((4 + (b) * 2 + (h)) * HTB)
#define PG8_STAGE(bufoff, gbase, voff) do { _Pragma("unroll") for (int _i = 0; _i < 2; ++_i) \
        __builtin_amdgcn_global_load_lds((const unsigned*)((const char*)(gbase) + (voff)[_i]), (LAS unsigned*)(lds + (bufoff) + ldsw + _i * 8192), 16, 0, 0); } while (0)
#define PG8_LDA(dst, b, h) do { _Pragma("unroll") for (int m = 0; m < 4; ++m) _Pragma("unroll") for (int k = 0; k < 2; ++k) dst[m][k] = *(const LAS bf16x8*)(lds + PG8_SA(b, h) + aoff + m * 2048 + k * 1024); } while (0)
#define PG8_LDB(dst, b, h) do { _Pragma("unroll") for (int n = 0; n < 2; ++n) _Pragma("unroll") for (int k = 0; k < 2; ++k) dst[n][k] = *(const LAS bf16x8*)(lds + PG8_SB(b, h) + boff + n * 2048 + k * 1024); } while (0)
#define PG8_MMA(ai, bj, At, Bt) do { __builtin_amdgcn_s_setprio(1); _Pragma("unroll") for (int m = 0; m < 4; ++m) _Pragma("unroll") for (int n = 0; n < 2; ++n) _Pragma("unroll") for (int k = 0; k < 2; ++k) \
        acc[ai][bj][m][n] = __builtin_amdgcn_mfma_f32_16x16x32_bf16(Bt[n][k], At[m][k], acc[ai][bj][m][n], 0, 0, 0); __builtin_amdgcn_s_setprio(0); } while (0)
#define PG8_WAIT_V(n) asm volatile("s_waitcnt vmcnt(" #n ")" ::: "memory")
#define PG8_WAIT_L(n) asm volatile("s_waitcnt lgkmcnt(" #n ")" ::: "memory")
#define PG8_BAR __builtin_amdgcn_s_barrier()
#define PG8_SCHED __builtin_amdgcn_sched_barrier(0)
    Unit cur, nxt; int ui = 0;
    if (!S.next(0, cur)) return;
    f32x4 acc[2][2][4][2];
    float zf = 0.f; asm volatile("" : "+v"(zf));
#pragma unroll
    for (int a = 0; a < 2; ++a)
#pragma unroll
        for (int b = 0; b < 2; ++b)
#pragma unroll
            for (int m = 0; m < 4; ++m)
#pragma unroll
                for (int n = 0; n < 2; ++n) acc[a][b][m][n] = (f32x4){zf, zf, zf, zf};
    const char* cA = cur.A; const char* cB = cur.B;
    PG8_STAGE(PG8_SB(0, 0), cB, voffB); PG8_STAGE(PG8_SB(0, 1), cB + hstepB, voffB); PG8_STAGE(PG8_SA(0, 0), cA, voffA); PG8_STAGE(PG8_SA(0, 1), cA + hstepA, voffA);
    if (wr == 1) PG8_BAR;
    PG8_WAIT_V(2); PG8_BAR;
    PG8_STAGE(PG8_SB(1, 0), cB + kstep, voffB); PG8_STAGE(PG8_SA(1, 0), cA + kstep, voffA); PG8_STAGE(PG8_SB(1, 1), cB + hstepB + kstep, voffB);
    PG8_WAIT_V(6); PG8_BAR;
    for (;;) {
        const bool has_next = S.next(ui + 1, nxt);
        const char* nA = has_next ? nxt.A : cA; const char* nB = has_next ? nxt.B : cB;
        for (int t = 0; t < nt; t += 2) {
            const bool last = (t == nt - 2);
            bf16x8 At[4][2], B0[2][2], B1[2][2];
            const char* a1 = cA + (size_t)(t + 1) * kstep;
            const char* a2 = last ? nA : cA + (size_t)(t + 2) * kstep; const char* b2 = last ? nB : cB + (size_t)(t + 2) * kstep;
            const char* a3 = a2 + kstep; const char* b3 = b2 + kstep;
            PG8_LDB(B0, 0, 0); PG8_LDB(B1, 0, 1); PG8_SCHED; PG8_LDA(At, 0, 0); PG8_STAGE(PG8_SA(1, 1), a1 + hstepA, voffA);
            PG8_WAIT_V(8); PG8_WAIT_L(0); PG8_BAR; PG8_MMA(0, 0, At, B0); PG8_MMA(0, 1, At, B1); PG8_BAR; PG8_SCHED;
            PG8_LDA(At, 0, 1); PG8_STAGE(PG8_SB(0, 0), b2, voffB); PG8_STAGE(PG8_SB(0, 1), b2 + hstepB, voffB); PG8_STAGE(PG8_SA(0, 0), a2, voffA);
            PG8_WAIT_V(8); PG8_WAIT_L(0); PG8_BAR; PG8_MMA(1, 0, At, B0); PG8_MMA(1, 1, At, B1); PG8_BAR; PG8_SCHED;
            PG8_LDB(B0, 1, 0); PG8_LDB(B1, 1, 1); PG8_SCHED; PG8_LDA(At, 1, 0); PG8_STAGE(PG8_SA(0, 1), a2 + hstepA, voffA);
            PG8_WAIT_V(8); PG8_WAIT_L(0); PG8_BAR; PG8_MMA(0, 0, At, B0); PG8_MMA(0, 1, At, B1); PG8_BAR; PG8_SCHED;
            PG8_LDA(At, 1, 1); PG8_STAGE(PG8_SB(1, 0), b3, voffB); PG8_STAGE(PG8_SB(1, 1), b3 + hstepB, voffB); PG8_STAGE(PG8_SA(1, 0), a3, voffA);
            PG8_WAIT_V(8); PG8_WAIT_L(0); PG8_BAR; PG8_MMA(1, 0, At, B0); PG8_MMA(1, 1, At, B1); PG8_BAR; PG8_SCHED;
        }
        if (wr == 0) PG8_BAR;
        E(acc, cur, wr, wc, fr, fq);
        if (!has_next) break;
#pragma unroll
        for (int a = 0; a < 2; ++a)
#pragma unroll
            for (int b = 0; b < 2; ++b)
#pragma unroll
                for (int m = 0; m < 4; ++m)
#pragma unroll
                    for (int n = 0; n < 2; ++n) acc[a][b][m][n] = (f32x4){zf, zf, zf, zf};
        cur = nxt; cA = nA; cB = nB; ++ui;
        if (wr == 1) PG8_BAR;
    }
    PG8_WAIT_V(0);
    PG8_BAR;
#undef PG8_SA
#undef PG8_SB
#undef PG8_STAGE
#undef PG8_LDA
#undef PG8_LDB
#undef PG8_MMA
#undef PG8_WAIT_V
#undef PG8_WAIT_L
#undef PG8_BAR
#undef PG8_SCHED
}

struct EpiStore {
    bf16_t* O; int ldc; const float* bias; float scale; int act;
    __device__ __forceinline__ void operator()(const f32x4 (&acc)[2][2][4][2], const Unit& u, int wr, int wc, int fr, int fq) const {
        const int row0 = u.pm * BM + wr * 64 + fr, col0 = u.pn * BM + wc * 32 + 8 * fq;
        f32x4 bv[2][2];
#pragma unroll
        for (int bj = 0; bj < 2; ++bj)
#pragma unroll
            for (int n = 0; n < 2; ++n) bv[bj][n] = bias ? *(const f32x4*)(bias + col0 + bj * HALF + 4 * n) : (f32x4){0.f, 0.f, 0.f, 0.f};
#pragma unroll
        for (int ai = 0; ai < 2; ++ai)
#pragma unroll
            for (int m = 0; m < 4; ++m) { bf16_t* rowp = O + (size_t)(row0 + ai * HALF + m * 16) * ldc + col0;
#pragma unroll
                for (int bj = 0; bj < 2; ++bj) { f32x4 v0 = acc[ai][bj][m][0] + bv[bj][0], v1 = acc[ai][bj][m][1] + bv[bj][1];
                    if (act == 1) {
#pragma unroll
                        for (int i = 0; i < 4; ++i) { v0[i] = 1.f / (1.f + __expf(-v0[i])); v1[i] = 1.f / (1.f + __expf(-v1[i])); } }
                    v0 = v0 * scale; v1 = v1 * scale; u32x4 w; w.x = cvt_pk_bf16(v0[0], v0[1]); w.y = cvt_pk_bf16(v0[2], v0[3]); w.z = cvt_pk_bf16(v1[0], v1[1]); w.w = cvt_pk_bf16(v1[2], v1[3]);
                    *(u32x4*)(rowp + bj * HALF) = w; }
                if (m & 1) asm volatile("" ::: "memory"); }
    }
};

struct EpiProj {
    unsigned char* ws; const float* cosT; const float* sinT; const float* bforget; float* logf;
    __device__ __forceinline__ void operator()(const f32x4 (&acc)[2][2][4][2], const Unit& u, int wr, int wc, int fr, int fq) const {
        const int pn = u.pn, row0 = u.pm * BM + wr * 64 + fr;
        if (pn == 21) {
            if (wc == 0 && fq == 0) {
#pragma unroll
                for (int ai = 0; ai < 2; ++ai)
#pragma unroll
                    for (int m = 0; m < 4; ++m) { const int r = row0 + ai * HALF + m * 16;
#pragma unroll
                        for (int n = 0; n < 2; ++n) { f32x4 v = acc[ai][0][m][n] + *(const f32x4*)(bforget + 4 * n); f32x4 o;
#pragma unroll
                            for (int i = 0; i < 4; ++i) { const float z = v[i]; o[i] = fminf(z, 0.f) - log1pf(__expf(-fabsf(z))); }
                            *(f32x4*)(logf + (size_t)r * 8 + 4 * n) = o; } }
            }
            return;
        }
        size_t off; int ld, tcol; bool rope; float sc = 1.f;
        if (pn < 2)       { off = P_QA; ld = 512; tcol = pn * 256;        rope = true;  sc = QSCALE; }
        else if (pn < 4)  { off = P_KA; ld = 512; tcol = (pn - 2) * 256;  rope = true; }
        else if (pn < 6)  { off = P_VA; ld = 512; tcol = (pn - 4) * 256;  rope = false; }
        else if (pn < 8)  { off = P_QB; ld = 512; tcol = (pn - 6) * 256;  rope = false; sc = QSCALE; }
        else if (pn < 10) { off = P_KB; ld = 512; tcol = (pn - 8) * 256;  rope = false; }
        else if (pn < 12) { off = P_VB; ld = 512; tcol = (pn - 10) * 256; rope = false; }
        else if (pn < 15) { off = P_QC; ld = 768; tcol = (pn - 12) * 256; rope = true;  sc = QSCALE; }
        else if (pn < 18) { off = P_KC; ld = 768; tcol = (pn - 15) * 256; rope = true; }
        else              { off = P_VC; ld = 768; tcol = (pn - 18) * 256; rope = false; }
        bf16_t* O = (bf16_t*)(ws + off);
        if (!rope) {
            const int col0 = tcol + wc * 32 + 8 * fq;
#pragma unroll
            for (int ai = 0; ai < 2; ++ai)
#pragma unroll
                for (int m = 0; m < 4; ++m) { bf16_t* rowp = O + (size_t)(row0 + ai * HALF + m * 16) * ld + col0;
#pragma unroll
                    for (int bj = 0; bj < 2; ++bj) { const f32x4 v0 = acc[ai][bj][m][0] * sc, v1 = acc[ai][bj][m][1] * sc;
                        u32x4 w; w.x = cvt_pk_bf16(v0[0], v0[1]); w.y = cvt_pk_bf16(v0[2], v0[3]); w.z = cvt_pk_bf16(v1[0], v1[1]); w.w = cvt_pk_bf16(v1[2], v1[3]);
                        *(u32x4*)(rowp + bj * HALF) = w; } }
        } else {
            const int col0 = tcol + wc * 64 + 8 * fq;
#pragma unroll
            for (int ai = 0; ai < 2; ++ai)
#pragma unroll
                for (int m = 0; m < 4; ++m) { const int r = row0 + ai * HALF + m * 16; bf16_t* rowp = O + (size_t)r * ld + col0;
                    const f32x4 c0 = *(const f32x4*)(cosT + (size_t)r * 32 + 8 * fq), c1 = *(const f32x4*)(cosT + (size_t)r * 32 + 8 * fq + 4);
                    const f32x4 s0 = *(const f32x4*)(sinT + (size_t)r * 32 + 8 * fq), s1 = *(const f32x4*)(sinT + (size_t)r * 32 + 8 * fq + 4);
                    const f32x4 x10 = acc[ai][0][m][0], x11 = acc[ai][0][m][1], x20 = acc[ai][1][m][0], x21 = acc[ai][1][m][1];
                    const f32x4 a0 = (x10 * c0 - x20 * s0) * sc, a1 = (x11 * c1 - x21 * s1) * sc, b0 = (x20 * c0 + x10 * s0) * sc, b1 = (x21 * c1 + x11 * s1) * sc;
                    u32x4 w; w.x = cvt_pk_bf16(a0[0], a0[1]); w.y = cvt_pk_bf16(a0[2], a0[3]); w.z = cvt_pk_bf16(a1[0], a1[1]); w.w = cvt_pk_bf16(a1[2], a1[3]);
                    *(u32x4*)(rowp) = w;
                    w.x = cvt_pk_bf16(b0[0], b0[1]); w.y = cvt_pk_bf16(b0[2], b0[3]); w.z = cvt_pk_bf16(b1[0], b1[1]); w.w = cvt_pk_bf16(b1[2], b1[3]);
                    *(u32x4*)(rowp + 32) = w;
                    asm volatile("" ::: "memory"); }
        }
    }
};

struct EpiGate {
    bf16_t* G; int br;
    __device__ __forceinline__ void operator()(const f32x4 (&acc)[2][2][4][2], const Unit& u, int wr, int wc, int fr, int fq) const {
        const int row0 = u.pm * BM + wr * 64 + fr, col0 = u.pn * BM + wc * 32 + 8 * fq;
#pragma unroll
        for (int ai = 0; ai < 2; ++ai)
#pragma unroll
            for (int m = 0; m < 4; ++m) { bf16_t* rowp = G + (size_t)(row0 + ai * HALF + m * 16) * 3072 + col0;
#pragma unroll
                for (int bj = 0; bj < 2; ++bj) {
                    const u32x4 gw = *(const u32x4*)(rowp + br * 1024 + bj * HALF);
                    float v[8];
#pragma unroll
                    for (int i = 0; i < 4; ++i) { v[i] = acc[ai][bj][m][0][i]; v[4 + i] = acc[ai][bj][m][1][i]; }
#pragma unroll
                    for (int i = 0; i < 4; ++i) { v[2 * i] *= __uint_as_float(gw[i] << 16); v[2 * i + 1] *= __uint_as_float(gw[i] & 0xffff0000u); }
                    if (br > 0) { const u32x4 pw = *(const u32x4*)(rowp + bj * HALF);
#pragma unroll
                        for (int i = 0; i < 4; ++i) { v[2 * i] += __uint_as_float(pw[i] << 16); v[2 * i + 1] += __uint_as_float(pw[i] & 0xffff0000u); } }
                    u32x4 w; w.x = cvt_pk_bf16(v[0], v[1]); w.y = cvt_pk_bf16(v[2], v[3]); w.z = cvt_pk_bf16(v[4], v[5]); w.w = cvt_pk_bf16(v[6], v[7]);
                    *(u32x4*)(rowp + bj * HALF) = w; }
                asm volatile("" ::: "memory"); }
    }
};

struct EpiResid {
    const float* xres; float* out; const int* rowtok;
    __device__ __forceinline__ void operator()(const f32x4 (&acc)[2][2][4][2], const Unit& u, int wr, int wc, int fr, int fq) const {
        const int row0 = u.pm * BM + wr * 64 + fr, col0 = u.pn * BM + wc * 32 + 8 * fq;
#pragma unroll
        for (int ai = 0; ai < 2; ++ai)
#pragma unroll
            for (int m = 0; m < 4; ++m) { const int r = row0 + ai * HALF + m * 16; const int tok = rowtok ? rowtok[r] : r;
                if (tok >= 0) { const size_t o = (size_t)tok * DM + col0;
#pragma unroll
                    for (int bj = 0; bj < 2; ++bj)
#pragma unroll
                        for (int n = 0; n < 2; ++n) { const f32x4 x = *(const f32x4*)(xres + o + bj * HALF + 4 * n); *(f32x4*)(out + o + bj * HALF + 4 * n) = x * DN_ALPHA + acc[ai][bj][m][n]; } }
                asm volatile("" ::: "memory"); }
    }
};

struct EpiSwiglu {
    bf16_t* H; const float* roww;
    __device__ __forceinline__ void operator()(const f32x4 (&acc)[2][2][4][2], const Unit& u, int wr, int wc, int fr, int fq) const {
        const int slot = u.pn >> 1, jh = u.pn & 1, row0 = u.pm * BM + wr * 64 + fr, col0 = slot * 256 + jh * 128 + wc * 32 + 8 * fq;
#pragma unroll
        for (int ai = 0; ai < 2; ++ai)
#pragma unroll
            for (int m = 0; m < 4; ++m) { const int r = row0 + ai * HALF + m * 16; const float w = roww[(size_t)r * 2 + slot]; float v[8];
#pragma unroll
                for (int n = 0; n < 2; ++n)
#pragma unroll
                    for (int i = 0; i < 4; ++i) { const float gt = acc[ai][0][m][n][i], up = acc[ai][1][m][n][i]; v[4 * n + i] = gt / (1.f + __expf(-gt)) * up * w; }
                u32x4 o; o.x = cvt_pk_bf16(v[0], v[1]); o.y = cvt_pk_bf16(v[2], v[3]); o.z = cvt_pk_bf16(v[4], v[5]); o.w = cvt_pk_bf16(v[6], v[7]);
                *(u32x4*)(H + (size_t)r * 512 + col0) = o; }
    }
};
}

namespace fa {
__device__ __forceinline__ int crow(int r, int hi) { return (r & 3) + 8 * (r >> 2) + 4 * hi; }
__device__ __forceinline__ s16x4 vtr(const LAS unsigned char* p) { return __builtin_bit_cast(s16x4, __builtin_amdgcn_ds_read_tr16_b64_v4i16((LAS s16x4*)p)); }

struct Prm {
    const bf16_t* Q; const bf16_t* K; const bf16_t* V;
    int qld, kld, vld;
    int rs;
    int q0;
    int kt0, kt1;
    int causal, win;
    const float* kbias;
};

template <int DQK, int DV, bool BIAS, bool QREG = true>
__device__ __forceinline__ void pass(LAS unsigned char* lds, const Prm& p, f32x16 (&o)[DV / 32], float& m_out, float& l_out) {
    constexpr int KROW = DQK * 2 + 16, VROW = DV * 2 + 64, KSZ = 64 * KROW, VSZ = 64 * VROW, BUFSZ = KSZ + VSZ;
    constexpr int KCH = DQK / 8, NKL = 64 * KCH / 512, VCH = DV / 8, NVL = 64 * VCH / 512;
    static_assert(2 * BUFSZ <= FA_SCR_OFF, "flash LDS");
    int tid = threadIdx.x; asm volatile("" : "+v"(tid));
    const int lane = tid & 63, wid = __builtin_amdgcn_readfirstlane(tid >> 6), r32 = lane & 31, hi = lane >> 5;
    const int qw0 = p.q0 + wid * 32, qi = qw0 + r32;
    bf16x8 qf[QREG ? DQK / 16 : 1];
    const bf16_t* qrow = p.Q + (size_t)qi * p.rs * p.qld + hi * 8;
    if (QREG) {
#pragma unroll
      for (int ks = 0; ks < DQK / 16; ++ks) qf[ks] = *(const bf16x8*)(qrow + ks * 16); }
#pragma unroll
    for (int db = 0; db < DV / 32; ++db)
#pragma unroll
        for (int r = 0; r < 16; ++r) o[db][r] = 0.f;
    float mrun = -1e30f, lrun = 0.f;
    LAS float* sc = (LAS float*)(lds + FA_SCR_OFF) + wid * 32;
    int kgo[NKL], klo[NKL], vgo[NVL], vlo[NVL];
#pragma unroll
    for (int i = 0; i < NKL; ++i) { const int cid = tid + 512 * i, row = cid / KCH, ch = cid % KCH; kgo[i] = row; klo[i] = row * KROW + ch * 16; kgo[i] = row * 65536 + ch * 8; }
#pragma unroll
    for (int i = 0; i < NVL; ++i) { const int cid = tid + 512 * i, row = cid / VCH, ch = cid % VCH; vlo[i] = KSZ + row * VROW + ch * 16; vgo[i] = row * 65536 + ch * 8; }
    u32x4 kreg[NKL], vreg[NVL];
#define FA_GLOAD(kt) do { \
        _Pragma("unroll") for (int i = 0; i < NKL; ++i) kreg[i] = *(const u32x4*)(p.K + (size_t)((kt) * 64 + (kgo[i] >> 16)) * p.rs * p.kld + (kgo[i] & 0xffff)); \
        _Pragma("unroll") for (int i = 0; i < NVL; ++i) vreg[i] = *(const u32x4*)(p.V + (size_t)((kt) * 64 + (vgo[i] >> 16)) * p.rs * p.vld + (vgo[i] & 0xffff)); } while (0)
#define FA_LSTORE(buf) do { \
        _Pragma("unroll") for (int i = 0; i < NKL; ++i) *(LAS u32x4*)(lds + (buf) * BUFSZ + klo[i]) = kreg[i]; \
        _Pragma("unroll") for (int i = 0; i < NVL; ++i) *(LAS u32x4*)(lds + (buf) * BUFSZ + vlo[i]) = vreg[i]; } while (0)
    FA_GLOAD(p.kt0); FA_LSTORE(0);
    __syncthreads();
    const int vboff = KSZ + (((lane & 15) >> 2) + 4 * hi) * VROW + (16 * ((lane >> 4) & 1) + 4 * (lane & 3)) * 2;
    for (int kt = p.kt0; kt < p.kt1; ++kt) {
        const int cur = (kt - p.kt0) & 1;
        const bool more = (kt + 1 < p.kt1);
        if (more) FA_GLOAD(kt + 1);
        const int k0 = kt * 64;
        const bool skip = p.causal && (k0 > qw0 + 31 || k0 + 63 < qw0 - p.win);
        if (!skip) {
            f32x16 p0, p1;
#pragma unroll
            for (int r = 0; r < 16; ++r) { p0[r] = 0.f; p1[r] = 0.f; }
            const LAS unsigned char* kb = lds + cur * BUFSZ + r32 * KROW + hi * 16;
            const bf16_t* qrow_t = qrow; asm volatile("" : "+v"(qrow_t));
#pragma unroll
            for (int ks = 0; ks < DQK / 16; ++ks) {
                const bf16x8 a0 = *(const LAS bf16x8*)(kb + ks * 32), a1 = *(const LAS bf16x8*)(kb + 32 * KROW + ks * 32);
                const bf16x8 qk = QREG ? qf[QREG ? ks : 0] : *(const bf16x8*)(qrow_t + ks * 16);
                p0 = __builtin_amdgcn_mfma_f32_32x32x16_bf16(a0, qk, p0, 0, 0, 0);
                p1 = __builtin_amdgcn_mfma_f32_32x32x16_bf16(a1, qk, p1, 0, 0, 0);
            }
            if (BIAS) {
                const float* kbp = p.kbias + k0 + 4 * hi;
#pragma unroll
                for (int j = 0; j < 4; ++j) { const f32x4 b0 = *(const f32x4*)(kbp + 8 * j), b1 = *(const f32x4*)(kbp + 32 + 8 * j);
#pragma unroll
                    for (int i = 0; i < 4; ++i) { p0[4 * j + i] += b0[i]; p1[4 * j + i] += b1[i]; } }
            }
            const bool need_mask = p.causal && (k0 + 63 > qw0 || k0 < qw0 + 31 - p.win);
            if (need_mask) {
                const int lo = qi - p.win;
#pragma unroll
                for (int r = 0; r < 16; ++r) { const int key = k0 + crow(r, hi);
                    if (key > qi || key < lo) p0[r] = -INFINITY;
                    if (key + 32 > qi || key + 32 < lo) p1[r] = -INFINITY; }
            }
            float mx = fmaxf(p0[0], p1[0]);
#pragma unroll
            for (int r = 1; r < 16; ++r) mx = fmaxf(mx, fmaxf(p0[r], p1[r]));
            mx = fmaxf(mx, __shfl_xor(mx, 32));
            const float mnew = fmaxf(mrun, mx), alpha = __builtin_amdgcn_exp2f(mrun - mnew);
            mrun = mnew;
            float rs = 0.f;
#pragma unroll
            for (int r = 0; r < 16; ++r) { p0[r] = __builtin_amdgcn_exp2f(p0[r] - mnew); p1[r] = __builtin_amdgcn_exp2f(p1[r] - mnew); rs += p0[r] + p1[r]; }
            lrun = lrun * alpha + rs;
            if (hi == 0) sc[r32] = alpha;
            bf16x8 pa[4];
            { u32x4 w;
              w.x = pk2(p0[0], p0[1]); w.y = pk2(p0[2], p0[3]); w.z = pk2(p0[4], p0[5]); w.w = pk2(p0[6], p0[7]); pa[0] = __builtin_bit_cast(bf16x8, w);
              w.x = pk2(p0[8], p0[9]); w.y = pk2(p0[10], p0[11]); w.z = pk2(p0[12], p0[13]); w.w = pk2(p0[14], p0[15]); pa[1] = __builtin_bit_cast(bf16x8, w);
              w.x = pk2(p1[0], p1[1]); w.y = pk2(p1[2], p1[3]); w.z = pk2(p1[4], p1[5]); w.w = pk2(p1[6], p1[7]); pa[2] = __builtin_bit_cast(bf16x8, w);
              w.x = pk2(p1[8], p1[9]); w.y = pk2(p1[10], p1[11]); w.z = pk2(p1[12], p1[13]); w.w = pk2(p1[14], p1[15]); pa[3] = __builtin_bit_cast(bf16x8, w); }
#pragma unroll
            for (int j = 0; j < 4; ++j) { const f32x4 a4 = *(const LAS f32x4*)(sc + 8 * j + 4 * hi);
#pragma unroll
                for (int db = 0; db < DV / 32; ++db)
#pragma unroll
                    for (int i = 0; i < 4; ++i) o[db][4 * j + i] *= a4[i]; }
            const LAS unsigned char* vb = lds + cur * BUFSZ + vboff;
#pragma unroll
            for (int sp = 0; sp < 4; ++sp)
#pragma unroll
                for (int db = 0; db < DV / 32; ++db) {
                    const s16x4 lo4 = vtr(vb + (16 * sp) * VROW + db * 64), hi4 = vtr(vb + (16 * sp + 8) * VROW + db * 64);
                    const bf16x8 vf = (bf16x8){lo4[0], lo4[1], lo4[2], lo4[3], hi4[0], hi4[1], hi4[2], hi4[3]};
                    o[db] = __builtin_amdgcn_mfma_f32_32x32x16_bf16(pa[sp], vf, o[db], 0, 0, 0);
                }
        }
        if (more) FA_LSTORE(cur ^ 1);
        __syncthreads();
    }
#undef FA_GLOAD
#undef FA_LSTORE
    m_out = mrun; l_out = lrun;
}

template <int NDB>
__device__ __forceinline__ float normalise(LAS unsigned char* lds, f32x16 (&o)[NDB], float l) {
    const int lane = threadIdx.x & 63, wid = __builtin_amdgcn_readfirstlane(threadIdx.x >> 6), r32 = lane & 31, hi = lane >> 5;
    LAS float* sc = (LAS float*)(lds + FA_SCR_OFF) + wid * 32;
    const float lt = l + __shfl_xor(l, 32);
    if (hi == 0) sc[r32] = 1.f / lt;
#pragma unroll
    for (int j = 0; j < 4; ++j) { const f32x4 a4 = *(const LAS f32x4*)(sc + 8 * j + 4 * hi);
#pragma unroll
        for (int db = 0; db < NDB; ++db)
#pragma unroll
            for (int i = 0; i < 4; ++i) o[db][4 * j + i] *= a4[i]; }
    return lt;
}
template <int NDB>
__device__ __forceinline__ void store_o(const f32x16 (&o)[NDB], bf16_t* O, int old, int rs, int q0) {
    const int lane = threadIdx.x & 63, wid = __builtin_amdgcn_readfirstlane(threadIdx.x >> 6), r32 = lane & 31, hi = lane >> 5;
#pragma unroll
    for (int r = 0; r < 16; ++r) { bf16_t* rowp = O + (size_t)(q0 + wid * 32 + crow(r, hi)) * rs * old + r32;
#pragma unroll
        for (int db = 0; db < NDB; ++db) rowp[db * 32] = (bf16_t)(pk2(o[db][r], 0.f) & 0xffffu); }
}
}

#include <hip/hip_bf16.h>
namespace attn_body {
using bf16=__hip_bfloat16;
using bf16x8=__attribute__((ext_vector_type(8)))short;
using s16x4=__attribute__((ext_vector_type(4)))short;
using f32x16=__attribute__((ext_vector_type(16)))float;
using u32x4=__attribute__((ext_vector_type(4)))unsigned;
constexpr int D=64;
constexpr int NW=8,QBLK=32,QB=QBLK*NW,KVBLK=64;
__device__ __forceinline__ int crow(int r,int hi){return (r&3)+8*(r>>2)+4*hi;}
#define SBAR() __builtin_amdgcn_sched_barrier(0)
__device__ __forceinline__ void cmask(f32x16&p0,f32x16&p1,int jb,int qrel,int hi){
  const float NEG=-INFINITY; int kb=64*jb+4*hi;
  #pragma unroll
  for(int r=0;r<16;++r){int kv=kb+(r&3)+8*(r>>2); if(kv>qrel)p0[r]=NEG; if(kv+32>qrel)p1[r]=NEG;}
}

constexpr int NSLOT=3, SLOTB=8192;
constexpr int LDS_K=0, LDS_V=NSLOT*SLOTB, LDS_WS=2*NSLOT*SLOTB, LDS_OST=LDS_WS+NW*64*4, LDS_KB=LDS_OST+NW*4096, LDS_BYTES=LDS_KB+16384;
constexpr float C2=0.125f*1.4426950408889634f;
__device__ __forceinline__ void glds16(const void*gsrc,unsigned lds_dst){unsigned keep;
  asm volatile("s_mov_b32 %0, m0\n\ts_mov_b32 m0, %2\n\ts_nop 0\n\tglobal_load_lds_dwordx4 %1, off\n\ts_mov_b32 m0, %0":"=&s"(keep):"v"(gsrc),"s"(lds_dst):"memory");}
__device__ __forceinline__ float max3f(float a,float b,float c){float r;asm("v_max3_f32 %0, %1, %2, %3":"=v"(r):"v"(a),"v"(b),"v"(c));return r;}
__device__ __forceinline__ float max2f(float a,float b){float r;asm("v_max_f32_e32 %0, %1, %2":"=v"(r):"v"(a),"v"(b));return r;}
__device__ __forceinline__ float fadd_s(float a,float b){float r;asm("v_add_f32_e32 %0, %1, %2":"=v"(r):"v"(a),"v"(b));return r;}
__device__ __forceinline__ float fsub_s(float a,float b){float r;asm("v_sub_f32_e32 %0, %1, %2":"=v"(r):"v"(a),"v"(b));return r;}
typedef float f32x2_t __attribute__((ext_vector_type(2))); typedef float f32x4_t __attribute__((ext_vector_type(4))); typedef __bf16 bf16x2_t __attribute__((ext_vector_type(2)));
__device__ __forceinline__ unsigned cvtpk_s(float lo,float hi){f32x2_t v={lo,hi};bf16x2_t b=__builtin_convertvector(v,bf16x2_t);return __builtin_bit_cast(unsigned,b);}
#define WAIT_BAR(N) asm volatile("s_waitcnt vmcnt(" #N ") lgkmcnt(0)\n\ts_barrier":::"memory")

__device__ __forceinline__ void qkt(f32x16&p0,f32x16&p1,const char*Kslot,const bf16x8*qr,const f32x16&c0,const f32x16&c1,int r32,int hi){
  const char*kb=Kslot+hi*1024+r32*16;
  #pragma unroll
  for(int d0=0;d0<4;++d0){
    const bf16x8 b0=*reinterpret_cast<const bf16x8*>(kb+d0*2048);
    const bf16x8 b1=*reinterpret_cast<const bf16x8*>(kb+d0*2048+512);
    if(d0==0){p0=__builtin_amdgcn_mfma_f32_32x32x16_bf16(b0,qr[0],c0,0,0,0);p1=__builtin_amdgcn_mfma_f32_32x32x16_bf16(b1,qr[0],c1,0,0,0);}
    else{p0=__builtin_amdgcn_mfma_f32_32x32x16_bf16(b0,qr[d0],p0,0,0,0);p1=__builtin_amdgcn_mfma_f32_32x32x16_bf16(b1,qr[d0],p1,0,0,0);}}
}
typedef __attribute__((address_space(3))) const char* lds_cptr;
typedef short v4i16_t __attribute__((ext_vector_type(4)));
__device__ __forceinline__ void kload8(bf16x8*kf,lds_cptr kp){
  kf[0]=*(const __attribute__((address_space(3))) bf16x8*)(kp);      kf[1]=*(const __attribute__((address_space(3))) bf16x8*)(kp+512);
  kf[2]=*(const __attribute__((address_space(3))) bf16x8*)(kp+2048); kf[3]=*(const __attribute__((address_space(3))) bf16x8*)(kp+2560);
  kf[4]=*(const __attribute__((address_space(3))) bf16x8*)(kp+4096); kf[5]=*(const __attribute__((address_space(3))) bf16x8*)(kp+4608);
  kf[6]=*(const __attribute__((address_space(3))) bf16x8*)(kp+6144); kf[7]=*(const __attribute__((address_space(3))) bf16x8*)(kp+6656);
}
__device__ __forceinline__ void kload2(bf16x8*kf,lds_cptr kp,int j){ kf[2*j]=*(const __attribute__((address_space(3))) bf16x8*)(kp+j*2048); kf[2*j+1]=*(const __attribute__((address_space(3))) bf16x8*)(kp+j*2048+512); }
__device__ __forceinline__ s16x4 vtr(lds_cptr p){ return __builtin_bit_cast(s16x4,__builtin_amdgcn_ds_read_tr16_b64_v4i16((__attribute__((address_space(3))) v4i16_t*)p)); }
__device__ __forceinline__ float rowmax(const f32x16&p0,const f32x16&p1){
  float a=max3f(p0[0],p0[1],p1[0]),b=max3f(p0[2],p0[3],p1[1]);a=max3f(a,p1[2],p1[3]);
  #pragma unroll
  for(int r=4;r<16;r+=4){a=max3f(a,p0[r],p0[r+1]);b=max3f(b,p0[r+2],p0[r+3]);a=max3f(a,p1[r],p1[r+1]);b=max3f(b,p1[r+2],p1[r+3]);}
  const float m=max2f(a,b);
  auto rr=__builtin_amdgcn_permlane32_swap(__float_as_uint(m),__float_as_uint(m),false,false);
  return max2f(__uint_as_float(rr[0]),__uint_as_float(rr[1]));
}
__device__ __forceinline__ void pv(f32x16*o,int vb,bf16x8 pa0,bf16x8 pa1,bf16x8 pa2,bf16x8 pa3){
  #pragma unroll
  for(int d0=0;d0<2;++d0){s16x4 lo[4],hi[4];
    #pragma unroll
    for(int ks=0;ks<4;++ks){
      asm volatile("ds_read_b64_tr_b16 %0,%1 offset:%c2":"=&v"(lo[ks]):"v"(vb),"i"(d0*4096+ks*1024):"memory");
      asm volatile("ds_read_b64_tr_b16 %0,%1 offset:%c2":"=&v"(hi[ks]):"v"(vb),"i"(d0*4096+ks*1024+512):"memory");}
    asm volatile("s_waitcnt lgkmcnt(0)":::"memory");SBAR();
    #define PK(k) (bf16x8){lo[k][0],lo[k][1],lo[k][2],lo[k][3],hi[k][0],hi[k][1],hi[k][2],hi[k][3]}
    o[d0]=__builtin_amdgcn_mfma_f32_32x32x16_bf16(pa0,PK(0),o[d0],0,0,0);
    o[d0]=__builtin_amdgcn_mfma_f32_32x32x16_bf16(pa1,PK(1),o[d0],0,0,0);
    o[d0]=__builtin_amdgcn_mfma_f32_32x32x16_bf16(pa2,PK(2),o[d0],0,0,0);
    o[d0]=__builtin_amdgcn_mfma_f32_32x32x16_bf16(pa3,PK(3),o[d0],0,0,0);
    #undef PK
  }
}

#ifndef ATTN_STORE16
#define ATTN_STORE16(p,v) (*(u32x4*)(p)=(v))
#endif
template<int THRL,bool BIAS> __device__ __forceinline__ void attn_unit(int qb,const bf16*Q,const bf16*__restrict__ K,const bf16*__restrict__ V,bf16*O,int qp,int kp,int vp,int op,const float*__restrict__ kbias,char*shm){
  int tid=threadIdx.x; asm volatile("":"+v"(tid)); const int lane=tid&63,r32=lane&31,hi=lane>>5; const int wid=__builtin_amdgcn_readfirstlane(tid>>6);
  const int q0=qb*QB;
  const bf16*Qw=Q+(long)(q0+wid*QBLK)*qp;
  const bf16*Kh=K,*Vh=V;
  const lds_cptr shm3=(lds_cptr)shm;
  const unsigned lds0=(unsigned)(uintptr_t)shm;
  float*wsf=(float*)(shm+LDS_WS)+wid*64;
  const bf16*ksrc=Kh+(long)lane*kp+wid*8;
  const bf16*vsrc=Vh+(long)(16*(wid&3)+(lane>>2))*vp+(wid>>2)*32+(lane&3)*8;
  const unsigned kdst=lds0+LDS_K+wid*1024, vdst=lds0+LDS_V+wid*1024;
  #define DMA_K(t,slot) glds16(ksrc+(long)(t)*KVBLK*kp,(unsigned)__builtin_amdgcn_readfirstlane(kdst+(slot)))
  #define DMA_V(t,slot) glds16(vsrc+(long)(t)*KVBLK*vp,(unsigned)__builtin_amdgcn_readfirstlane(vdst+(slot)))
  const int vb0=(int)(lds0+LDS_V)+((lane>>4)&1)*32+(lane&3)*8+(4*hi+((lane&15)>>2))*64;
  const char*Kbase=shm+LDS_K; bf16x8 kf[8];
  const lds_cptr kp0=shm3+LDS_K+hi*1024+r32*16; const lds_cptr vp0=shm3+LDS_V+((lane>>4)&1)*32+(lane&3)*8+(4*hi+((lane&15)>>2))*64;
  const int NT=(q0+QB)/KVBLK;
  DMA_K(0,0);DMA_V(0,0);DMA_K(1,SLOTB);
  bf16x8 qr[4];
  #pragma unroll
  for(int d0=0;d0<4;++d0)qr[d0]=*reinterpret_cast<const bf16x8*>(&Qw[(long)r32*qp+d0*16+hi*8]);
  if(BIAS){ __attribute__((address_space(3))) float*kbw=(__attribute__((address_space(3))) float*)(shm3+LDS_KB); for(int i=tid;i<q0+QB;i+=NW*64)kbw[i]=kbias[i]; }
  const __attribute__((address_space(3))) float*kbl=(const __attribute__((address_space(3))) float*)(shm3+LDS_KB)+4*hi;
  float mhat=0.f,l_reg=0.f;f32x16 o[2];o[0]=f32x16{};o[1]=f32x16{};f32x16 negm=f32x16{};asm volatile("":"+v"(negm));
  const int qrel=wid*QBLK+r32;
  #define CMASK(P0,P1,t) do{int jb_=(t)-(NT-4); if(jb_>=0)cmask(P0,P1,jb_,qrel,hi);}while(0)
  #define CINIT(C0,C1,t) do{ if(BIAS){ const __attribute__((address_space(3))) float*kb_=kbl+(t)*64; \
      _Pragma("unroll") for(int j_=0;j_<4;++j_){ const __attribute__((address_space(3))) f32x4_t*b4_=(const __attribute__((address_space(3))) f32x4_t*)(kb_+8*j_); const f32x4_t x_=b4_[0],y_=b4_[8]; \
        _Pragma("unroll") for(int i_=0;i_<4;++i_){ C0[4*j_+i_]=x_[i_]-mhat; C1[4*j_+i_]=y_[i_]-mhat; } } } \
    else { C0=negm; C1=negm; } }while(0)
  bool resc=false;
  #define START(P0,P1) do{ const float rm=rowmax(P0,P1); resc=false; \
    { const float dl=rm; mhat=fadd_s(mhat,dl); \
      _Pragma("unroll") for(int r=0;r<16;++r){P0[r]=fsub_s(P0[r],dl);P1[r]=fsub_s(P1[r],dl);} \
      _Pragma("unroll") for(int r=0;r<16;++r)negm[r]=-mhat; asm volatile("":"+v"(negm)); } \
    _Pragma("unroll") for(int r=0;r<16;++r)P0[r]=__builtin_amdgcn_exp2f(P0[r]); }while(0)
  #define RESC() do{ if(resc){ asm volatile("s_waitcnt lgkmcnt(0)":::"memory"); \
      _Pragma("unroll") for(int d_=0;d_<2;++d_) _Pragma("unroll") for(int r=0;r<16;++r)o[d_][r]*=wsf[crow(r,hi)]; } }while(0)
  f32x16 pA0,pA1,pB0,pB1;
  int sl_prev=0,sl_cur=0,sl_next=SLOTB;
  #define ROT() do{sl_prev=sl_cur;sl_cur=sl_next;sl_next=(sl_next==(NSLOT-1)*SLOTB)?0:sl_next+SLOTB;}while(0)
  DMA_K(2,2*SLOTB);
  WAIT_BAR(3);
  CINIT(pA0,pA1,0); qkt(pA0,pA1,Kbase,qr,pA0,pA1,r32,hi);asm volatile("s_nop 15\n\ts_nop 7":"+v"(pA0),"+v"(pA1));CMASK(pA0,pA1,0);
  START(pA0,pA1);
  _Pragma("unroll") for(int r=0;r<16;++r)pA1[r]=__builtin_amdgcn_exp2f(pA1[r]);
  WAIT_BAR(0);
  DMA_K(3,0);DMA_V(1,SLOTB);
  ROT();
  kload8(kf,kp0+sl_cur);
  WAIT_BAR(2);
  s16x4 vlo[8],vhi[8]; u32x4 pw0,pw1,pw2,pw3;
  #define PKW(P,B) cvtpk_s(P[B],P[B+1])
  #define PAF(k) __builtin_bit_cast(bf16x8,pw##k)
  #define VFR(i) (bf16x8){vlo[i][0],vlo[i][1],vlo[i][2],vlo[i][3],vhi[i][0],vhi[i][1],vhi[i][2],vhi[i][3]}
  #define PIN(x) asm volatile("":"+v"(x))
  #define MX3(a,b,c) __builtin_fmaxf(__builtin_fmaxf((a),(b)),(c))
  #define GAPA(MF,A0,A1,A2,A3,W0,W1,PW) do{ MF; sacc+=A0; sacc+=A1; sacc+=A2; sacc+=A3; PIN(sacc); W0; W1; PIN(PW); SBAR(); }while(0)
  #define EX(v) __builtin_amdgcn_exp2f(v)
  #define GAPB(MF,X,B) do{ MF; X[B]=EX(X[B]); X[B+1]=EX(X[B+1]); X[B+2]=EX(X[B+2]); X[B+3]=EX(X[B+3]); PIN(X); SBAR(); }while(0)
  #define VRD(i) do{ vlo[i]=vtr(vp_+(((i)>>2)*4096+((i)&3)*1024)); vhi[i]=vtr(vp_+(((i)>>2)*4096+((i)&3)*1024+512)); }while(0)
  #define KRD(G,j) do{ if(G){ kload2(kf,kp0+sl_next,j); SBAR(); } }while(0)
  #define STEP(C0,C1,P0,P1,t,GK,GV,GL) do{ SBAR(); CINIT(C0,C1,t); SBAR(); \
    const lds_cptr vp_=vp0+sl_prev; \
    VRD(0); SBAR(); float sacc=(P0[0]+P0[1]); \
    GAPA(C0=__builtin_amdgcn_mfma_f32_32x32x16_bf16(kf[0],qr[0],C0,0,0,0), P0[2],P0[3],P0[4],P0[5],     pw0[0]=PKW(P0,0), pw0[1]=PKW(P0,2), pw0); \
    VRD(4); SBAR(); GAPA(C1=__builtin_amdgcn_mfma_f32_32x32x16_bf16(kf[1],qr[0],C1,0,0,0), P0[6],P0[7],P0[8],P0[9],     pw0[2]=PKW(P0,4), pw0[3]=PKW(P0,6), pw0); \
    VRD(1); SBAR(); GAPA(C0=__builtin_amdgcn_mfma_f32_32x32x16_bf16(kf[2],qr[1],C0,0,0,0),   P0[10],P0[11],P0[12],P0[13], pw1[0]=PKW(P0,8), pw1[1]=PKW(P0,10), pw1); \
    VRD(5); SBAR(); GAPA(C1=__builtin_amdgcn_mfma_f32_32x32x16_bf16(kf[3],qr[1],C1,0,0,0),   P0[14],P0[15],P1[0],P1[1],   pw1[2]=PKW(P0,12),pw1[3]=PKW(P0,14), pw1); \
    VRD(2); SBAR(); GAPA(C0=__builtin_amdgcn_mfma_f32_32x32x16_bf16(kf[4],qr[2],C0,0,0,0),   P1[2],P1[3],P1[4],P1[5],     pw2[0]=PKW(P1,0), pw2[1]=PKW(P1,2), pw2); \
    VRD(6); SBAR(); GAPA(C1=__builtin_amdgcn_mfma_f32_32x32x16_bf16(kf[5],qr[2],C1,0,0,0),   P1[6],P1[7],P1[8],P1[9],     pw2[2]=PKW(P1,4), pw2[3]=PKW(P1,6), pw2); \
    VRD(3); SBAR(); GAPA(C0=__builtin_amdgcn_mfma_f32_32x32x16_bf16(kf[6],qr[3],C0,0,0,0),   P1[10],P1[11],P1[12],P1[13], pw3[0]=PKW(P1,8), pw3[1]=PKW(P1,10), pw3); \
    VRD(7); SBAR(); GAPA(C1=__builtin_amdgcn_mfma_f32_32x32x16_bf16(kf[7],qr[3],C1,0,0,0),   P1[14],P1[15],0.f,0.f,       pw3[2]=PKW(P1,12),pw3[3]=PKW(P1,14), pw3); \
    l_reg+=sacc; \
    if(GK){DMA_K((t)+3,sl_cur);} if(GV){DMA_V((t)+1,sl_next);} \
    CMASK(C0,C1,t); \
    { float a=MX3(C0[0],C0[1],C1[0]),b=MX3(C0[2],C0[3],C1[1]); a=MX3(a,C1[2],C1[3]); \
      _Pragma("unroll") for(int r=4;r<16;r+=4){a=MX3(a,C0[r],C0[r+1]);b=MX3(b,C0[r+2],C0[r+3]);a=MX3(a,C1[r],C1[r+1]);b=MX3(b,C1[r+2],C1[r+3]);} \
      float rm=__builtin_fmaxf(a,b); { auto rr=__builtin_amdgcn_permlane32_swap(__float_as_uint(rm),__float_as_uint(rm),false,false); rm=__builtin_fmaxf(__uint_as_float(rr[0]),__uint_as_float(rr[1])); } \
      resc=false; \
      if(__builtin_expect(__any(rm>(float)THRL),0)){ const float dl=__builtin_fmaxf(rm,0.f); mhat+=dl; \
        _Pragma("unroll") for(int r=0;r<16;++r){C0[r]-=dl;C1[r]-=dl;} \
        _Pragma("unroll") for(int r=0;r<16;++r)negm[r]=-mhat; asm volatile("":"+v"(negm)); \
        const float f=__builtin_amdgcn_exp2f(-dl); l_reg*=f; if(hi==0)wsf[r32]=f; resc=true; } } \
    SBAR(); \
    GAPB(o[0]=__builtin_amdgcn_mfma_f32_32x32x16_bf16(PAF(0),VFR(0),o[0],0,0,0), C0,0); \
    GAPB(o[1]=__builtin_amdgcn_mfma_f32_32x32x16_bf16(PAF(0),VFR(4),o[1],0,0,0), C0,4); \
    KRD(GL,0); GAPB(o[0]=__builtin_amdgcn_mfma_f32_32x32x16_bf16(PAF(1),VFR(1),o[0],0,0,0), C0,8); \
    KRD(GL,1); GAPB(o[1]=__builtin_amdgcn_mfma_f32_32x32x16_bf16(PAF(1),VFR(5),o[1],0,0,0), C0,12); \
    KRD(GL,2); GAPB(o[0]=__builtin_amdgcn_mfma_f32_32x32x16_bf16(PAF(2),VFR(2),o[0],0,0,0), C1,0); \
    KRD(GL,3); GAPB(o[1]=__builtin_amdgcn_mfma_f32_32x32x16_bf16(PAF(2),VFR(6),o[1],0,0,0), C1,4); \
    GAPB(o[0]=__builtin_amdgcn_mfma_f32_32x32x16_bf16(PAF(3),VFR(3),o[0],0,0,0), C1,8); \
    GAPB(o[1]=__builtin_amdgcn_mfma_f32_32x32x16_bf16(PAF(3),VFR(7),o[1],0,0,0), C1,12); \
    }while(0)
  int t=1;
  #undef CMASK
  #define CMASK(P0,P1,t) do{}while(0)
  for(;t+5<NT;t+=2){
    STEP(pB0,pB1,pA0,pA1,t,true,true,true);     WAIT_BAR(2); RESC(); ROT();
    STEP(pA0,pA1,pB0,pB1,t+1,true,true,true);   WAIT_BAR(2); RESC(); ROT();
  }
  #undef CMASK
  #define CMASK(P0,P1,t) do{int jb_=(t)-(NT-4); if(jb_>=0)cmask(P0,P1,jb_,qrel,hi);}while(0)
  #define ENDW(tt) do{ if((tt)+3<NT){WAIT_BAR(2);} else if((tt)+2<NT){WAIT_BAR(1);} else {WAIT_BAR(0);} }while(0)
  for(;t+1<NT;t+=2){
    STEP(pB0,pB1,pA0,pA1,t,(t+3<NT),(t+1<NT),(t+1<NT));       ENDW(t);   RESC(); ROT();
    STEP(pA0,pA1,pB0,pB1,t+1,(t+4<NT),(t+2<NT),(t+2<NT));     ENDW(t+1); RESC(); ROT();
  }
  STEP(pB0,pB1,pA0,pA1,NT-1,false,false,false); RESC();
  { float sacc=pB0[0]+pB0[1]; _Pragma("unroll") for(int r=2;r<16;++r)sacc+=pB0[r]; _Pragma("unroll") for(int r=0;r<16;++r)sacc+=pB1[r]; l_reg+=sacc;
    pw0=(u32x4){PKW(pB0,0),PKW(pB0,2),PKW(pB0,4),PKW(pB0,6)};pw1=(u32x4){PKW(pB0,8),PKW(pB0,10),PKW(pB0,12),PKW(pB0,14)};pw2=(u32x4){PKW(pB1,0),PKW(pB1,2),PKW(pB1,4),PKW(pB1,6)};pw3=(u32x4){PKW(pB1,8),PKW(pB1,10),PKW(pB1,12),PKW(pB1,14)};
    SBAR(); pv(o,vb0+sl_cur,PAF(0),PAF(1),PAF(2),PAF(3)); }
  #undef PKW
  #undef PAF
  #undef VFR
  #undef PIN
  #undef MX3
  #undef GAPA
  #undef GAPB
  #undef EX
  #undef VRD
  #undef KRD
  #undef STEP
  #undef ENDW
  {auto rr=__builtin_amdgcn_permlane32_swap(__float_as_uint(l_reg),__float_as_uint(l_reg),false,false);l_reg=__uint_as_float(rr[0])+__uint_as_float(rr[1]);}
  if(hi==0)wsf[32+r32]=l_reg;asm volatile("s_waitcnt lgkmcnt(0)":::"memory");
  float rli[16];
  #pragma unroll
  for(int r=0;r<16;++r)rli[r]=__builtin_amdgcn_rcpf(wsf[32+crow(r,hi)]);
  bf16*Ow=O+(long)(q0+wid*QBLK)*op;
  { bf16*stg=(bf16*)(shm+LDS_OST)+wid*2048;
    #pragma unroll
    for(int r=0;r<16;++r){const int orow=crow(r,hi);
      #pragma unroll
      for(int d0=0;d0<2;++d0)stg[orow*64+d0*32+r32]=__float2bfloat16(o[d0][r]*rli[r]);}
    asm volatile("s_waitcnt lgkmcnt(0)":::"memory");
    #pragma unroll
    for(int i=0;i<4;++i){const int row=i*8+(lane>>3),ch=lane&7; const u32x4 v=*(const u32x4*)(stg+row*64+ch*8); ATTN_STORE16(Ow+(long)row*op+ch*8,v);} }
  asm volatile("s_waitcnt lgkmcnt(0)\n\ts_barrier":::"memory");
  #undef DMA_K
  #undef DMA_V
  #undef CMASK
  #undef CINIT
  #undef START
  #undef RESC
  #undef ROT
}
constexpr int ATTN_LDS_BYTES=LDS_BYTES;
#undef SBAR
#undef WAIT_BAR
}

struct Args {
    const float* x; const float* mem; const int* positions;
    const float* w_in; const float* b_forget; const float* diff_lambda; const float* diff_subln;
    const float* w_branch_a; const float* w_branch_b; const float* w_branch_c; const float* w_gate; const float* b_gate; const float* w_out;
    const float* w_xq; const float* w_xk; const float* w_xv; const float* w_xo;
    const float* w_rg; const float* b_rg; const float* w_re; const float* b_re;
    const float* w_eg; const float* w_eu; const float* w_ed; const float* ln_g; const float* ln_b;
    float* out; unsigned char* ws;
};

__device__ __forceinline__ void tr_item(const float* W, int ldw, int k0, int c0, int ncv, bf16_t* WT, int ldt, int r0, int kk0, LAS float* scr, int lane) {
    const int c = lane & 31;
#pragma unroll 8
    for (int i = 0; i < 32; ++i) { const int kk = 2 * i + (lane >> 5); scr[kk * 33 + c] = (c < ncv) ? W[(size_t)(k0 + kk) * ldw + c0 + c] : 0.f; }
    LDS_WAIT(); asm volatile("" ::: "memory");
    const int c8 = lane & 7;
#pragma unroll
    for (int j = 0; j < 4; ++j) { const int n = (lane >> 3) + 8 * j; const LAS float* s = scr + (8 * c8) * 33 + n;
        u32x4 o; o.x = pk2(s[0 * 33], s[1 * 33]); o.y = pk2(s[2 * 33], s[3 * 33]); o.z = pk2(s[4 * 33], s[5 * 33]); o.w = pk2(s[6 * 33], s[7 * 33]);
        *(u32x4*)(WT + (size_t)(r0 + n) * ldt + kk0 + 8 * c8) = o; }
    LDS_WAIT(); asm volatile("" ::: "memory");
}

__device__ __forceinline__ void convert_layer(const Args& a, int l, LAS unsigned char* lds, int gw, int NGW, int wave, int lane) {
    LAS float* scr = (LAS float*)(lds + wave * 16384);
    bf16_t* Wb = (bf16_t*)(a.ws + OFF_W);
    constexpr int N0 = 176 * 16, N1 = 96 * 16, N2 = 512, N7 = 256, N9 = 128, N10 = 4096, N11 = 6144;
    constexpr int TOTAL = N0 + N1 + 5 * N2 + 2 * N7 + N9 + N10 + N11;
    for (int it = gw; it < TOTAL; it += NGW) {
        int r = it;
        if (r < N0) {
            const int grp = r >> 4, kb = r & 15, t = grp >> 3, q = grp & 7; int c0, ncv = 32;
            if (t == 21) { c0 = 3072; ncv = (q == 0) ? 8 : 0; }
            else { int base, tf; bool rope;
                if (t < 2) { base = 0; tf = 0; rope = true; } else if (t < 4) { base = 512; tf = 2; rope = true; } else if (t < 6) { base = 1024; tf = 4; rope = false; }
                else if (t < 8) { base = 1536; tf = 6; rope = false; } else if (t < 10) { base = 2048; tf = 8; rope = false; } else if (t < 12) { base = 2560; tf = 10; rope = false; }
                else if (t < 15) { base = 3080; tf = 12; rope = true; } else if (t < 18) { base = 3848; tf = 15; rope = true; } else { base = 4616; tf = 18; rope = false; }
                c0 = base + (t - tf) * 256 + (rope ? ((q & 3) * 64 + (q >> 2) * 32) : 32 * q); }
            tr_item(a.w_in + (size_t)l * DM * IN_COLS, IN_COLS, kb * 64, c0, ncv, Wb + W_IN / 2, 1024, grp * 32, kb * 64, scr, lane); continue; }
        r -= N0;
        if (r < N1) { const int grp = r >> 4, kb = r & 15; tr_item(a.w_gate + (size_t)l * DM * 3072, 3072, kb * 64, grp * 32, 32, Wb + W_GATE / 2, 1024, grp * 32, kb * 64, scr, lane); continue; }
        r -= N1;
        if (r < 5 * N2) { const int which = r / N2, rr = r % N2, grp = rr >> 4, kb = rr & 15;
            const float* src = (which == 0 ? a.w_out : which == 1 ? a.w_xq : which == 2 ? a.w_xk : which == 3 ? a.w_xv : a.w_xo) + (size_t)l * DM * DM;
            const size_t dst = which == 0 ? W_OUT : which == 1 ? W_XQ : which == 2 ? W_XK : which == 3 ? W_XV : W_XO;
            tr_item(src, 1024, kb * 64, grp * 32, 32, Wb + dst / 2, 1024, grp * 32, kb * 64, scr, lane); continue; }
        r -= 5 * N2;
        if (r < 2 * N7) { const int which = r / N7, rr = r % N7, grp = rr >> 3, kb = rr & 7;
            tr_item((which ? a.w_branch_b : a.w_branch_a) + (size_t)l * 512 * DM, 1024, kb * 64, grp * 32, 32, Wb + (which ? W_BB : W_BA) / 2, 512, grp * 32, kb * 64, scr, lane); continue; }
        r -= 2 * N7;
        if (r < N9) { const int grp = r >> 2, kb = r & 3; tr_item(a.w_branch_c + (size_t)l * 256 * DM, 1024, kb * 64, grp * 32, 32, Wb + W_BC / 2, 256, grp * 32, kb * 64, scr, lane); continue; }
        r -= N9;
        if (r < N10) {
            const int kb = r & 15, q = (r >> 4) & 7, jh = (r >> 7) & 1, e = r >> 8;
            const float* src = ((q < 4) ? a.w_eg : a.w_eu) + ((size_t)l * 16 + e) * DM * 256;
            tr_item(src, 256, kb * 64, jh * 128 + 32 * (q & 3), 32, Wb + W_E1 / 2, 1024, (e * 2 + jh) * 256 + q * 32, kb * 64, scr, lane); continue; }
        r -= N10;
        {
            const int kb = r & 3, grp = (r >> 2) & 31, slot = (r >> 7) & 1, bk = r >> 8, g = bk / 6, pr = bk % 6;
            const int lo = pr < 3 ? 0 : (pr < 5 ? 1 : 2), hi = pr < 3 ? pr + 1 : (pr < 5 ? pr - 1 : 3);
            const int e = g * 4 + (slot ? hi : lo);
            tr_item(a.w_ed + ((size_t)l * 16 + e) * 256 * DM, 1024, kb * 64, grp * 32, 32, Wb + W_DP / 2 + (size_t)bk * 1024 * 512, 512, grp * 32, slot * 256 + kb * 64, scr, lane); }
    }
}

__device__ __forceinline__ void rows_to_bf16(const float* src, bf16_t* dst, int nrows, int gw, int NGW, int lane) {
    for (int m = gw; m < nrows; m += NGW) {
        const f32x4* xr = (const f32x4*)(src + (size_t)m * DM) + lane; u32x2* o8 = (u32x2*)(dst + (size_t)m * DM) + lane;
#pragma unroll
        for (int j = 0; j < 4; ++j) { const f32x4 v = xr[64 * j]; u32x2 w; w.x = pk2(v[0], v[1]); w.y = pk2(v[2], v[3]); o8[64 * j] = w; }
    }
}

__device__ __forceinline__ void wave_sum4(float (&x)[4]) {
#pragma unroll
    for (int o = 1; o < 64; o <<= 1) {
#pragma unroll
        for (int r = 0; r < 4; ++r) x[r] += __shfl_xor(x[r], o); }
}
__device__ __forceinline__ float dot4(f32x4 a, f32x4 b) { return (a[0] * b[0] + a[1] * b[1]) + (a[2] * b[2] + a[3] * b[3]); }
template <bool ROUTE>
__device__ __forceinline__ void ln_phase(const Args& a, unsigned char* ws, int l, int sub, int cs, int gw, int NGW, int lane, int tid, LAS unsigned* hist) {
    const f32x4* gam = (const f32x4*)(a.ln_g + ((size_t)l * 3 + sub) * DM) + lane; const f32x4* bet = (const f32x4*)(a.ln_b + ((size_t)l * 3 + sub) * DM) + lane;
    bf16_t* xb = (bf16_t*)(ws + OFF_XB);
    f32x4 gg[4], bb[4];
#pragma unroll
    for (int j = 0; j < 4; ++j) { gg[j] = gam[64 * j]; bb[j] = bet[64 * j]; }
    for (int m0 = gw * 4; m0 < T; m0 += NGW * 4) {
        f32x4 v[4][4]; float s[4];
#pragma unroll
        for (int r = 0; r < 4; ++r) { const f32x4* xr = (const f32x4*)(a.out + (size_t)(m0 + r) * DM) + lane;
#pragma unroll
            for (int j = 0; j < 4; ++j) v[r][j] = xr[64 * j]; }
#pragma unroll
        for (int r = 0; r < 4; ++r) { s[r] = 0.f;
#pragma unroll
            for (int j = 0; j < 4; ++j) s[r] += (v[r][j][0] + v[r][j][1]) + (v[r][j][2] + v[r][j][3]); }
        wave_sum4(s);
        float q[4];
#pragma unroll
        for (int r = 0; r < 4; ++r) { const float mean = s[r] * (1.f / DM); q[r] = 0.f;
#pragma unroll
            for (int j = 0; j < 4; ++j) { v[r][j] = v[r][j] - mean; q[r] += dot4(v[r][j], v[r][j]); } }
        wave_sum4(q);
#pragma unroll
        for (int r = 0; r < 4; ++r) { const float rstd = 1.f / sqrtf(q[r] * (1.f / DM) + LN_EPS);
            f32x4* xr = (f32x4*)(a.out + (size_t)(m0 + r) * DM) + lane; u32x2* o8 = (u32x2*)(xb + (size_t)(m0 + r) * DM) + lane;
#pragma unroll
            for (int j = 0; j < 4; ++j) { v[r][j] = v[r][j] * rstd * gg[j] + bb[j]; xr[64 * j] = v[r][j]; u32x2 w; w.x = pk2(v[r][j][0], v[r][j][1]); w.y = pk2(v[r][j][2], v[r][j][3]); o8[64 * j] = w; } }
        if (ROUTE) {
            const f32x4* rgT = (const f32x4*)(ws + OFF_RGT);
            const f32x4* reT = (const f32x4*)(ws + OFF_RGT + 16384);
            unsigned ul = (unsigned)lane; asm volatile("" : "+v"(ul));
            float gl[4][4];
#pragma unroll
            for (int k = 0; k < 4; ++k) {
#pragma unroll
                for (int r = 0; r < 4; ++r) gl[k][r] = 0.f;
#pragma unroll
                for (int j = 0; j < 4; ++j) { const f32x4 w = rgT[(unsigned)(k * 256 + 64 * j) + ul];
#pragma unroll
                    for (int r = 0; r < 4; ++r) gl[k][r] += dot4(w, v[r][j]); }
                wave_sum4(gl[k]); asm volatile("" ::: "memory"); }
            int gi[4]; float ggate[4];
#pragma unroll
            for (int r = 0; r < 4; ++r) { float g4[4];
#pragma unroll
                for (int k = 0; k < 4; ++k) g4[k] = gl[k][r] + a.b_rg[l * 4 + k];
                int gidx = 0; float gm = g4[0];
#pragma unroll
                for (int k = 1; k < 4; ++k) if (g4[k] > gm) { gm = g4[k]; gidx = k; }
                float gs = 0.f;
#pragma unroll
                for (int k = 0; k < 4; ++k) gs += __expf(g4[k] - gm);
                gi[r] = __builtin_amdgcn_readfirstlane(gidx); ggate[r] = 1.f / gs; }
            float el[4][4];
#pragma unroll
            for (int e = 0; e < 4; ++e) {
#pragma unroll
                for (int r = 0; r < 4; ++r) { el[e][r] = 0.f;
#pragma unroll
                    for (int j = 0; j < 4; ++j) el[e][r] += dot4(reT[(unsigned)((gi[r] * 4 + e) * 256 + 64 * j) + ul], v[r][j]); }
                wave_sum4(el[e]); asm volatile("" ::: "memory"); }
#pragma unroll
            for (int r = 0; r < 4; ++r) { float e4[4];
#pragma unroll
                for (int k = 0; k < 4; ++k) e4[k] = el[k][r] + a.b_re[(l * 4 + gi[r]) * 4 + k];
                int i1 = 0; float v1 = e4[0];
#pragma unroll
                for (int k = 1; k < 4; ++k) if (e4[k] > v1) { v1 = e4[k]; i1 = k; }
                int i2 = -1; float v2 = -INFINITY;
#pragma unroll
                for (int k = 0; k < 4; ++k) if (k != i1 && e4[k] > v2) { v2 = e4[k]; i2 = k; }
                const float w1 = 1.f / (1.f + __expf(v2 - v1)), w2 = 1.f - w1;
                const int lo = i1 < i2 ? i1 : i2, hi = i1 < i2 ? i2 : i1;
                const float wlo = (i1 < i2 ? w1 : w2) * ggate[r], whi = (i1 < i2 ? w2 : w1) * ggate[r];
                const int pr = lo == 0 ? hi - 1 : (lo == 1 ? hi + 1 : 5);
                const int bk = gi[r] * 6 + pr;
                if (lane == 0) { u32x4 ti; ti.x = (unsigned)bk; ti.y = __float_as_uint(wlo); ti.z = __float_as_uint(whi); ti.w = 0u;
                    *(u32x4*)(ws + OFF_TOKINFO + (size_t)(m0 + r) * 16) = ti;
                    __hip_atomic_fetch_add(hist + bk, 1u, __ATOMIC_RELAXED, __HIP_MEMORY_SCOPE_WORKGROUP); } }
        }
    }
    if (ROUTE) {
        __syncthreads();
        if (tid < NBUCKET) { const unsigned c = hist[tid]; hist[tid] = 0u;
            if (c) __hip_atomic_fetch_add((unsigned*)(ws + OFF_CTL) + CW_CNT + cs * 32 + tid, c, __ATOMIC_RELAXED, __HIP_MEMORY_SCOPE_AGENT); }
        __syncthreads();
    }
}

__device__ __forceinline__ void moe_tables(const Args& a, int cs, LAS int* tb) {
    unsigned* ctl = (unsigned*)(a.ws + OFF_CTL);
    if (threadIdx.x == 0) {
        int start = 0;
#pragma clang loop unroll(disable)
        for (int b = 0; b < NBUCKET; ++b) { const int c = (int)__hip_atomic_load(ctl + CW_CNT + cs * 32 + b, __ATOMIC_RELAXED, __HIP_MEMORY_SCOPE_AGENT);
            tb[b] = start; const int nt = (c + 255) >> 8;
#pragma clang loop unroll(disable)
            for (int t = 0; t < nt; ++t) tb[64 + (start >> 8) + t] = b;
            start += nt << 8; }
        tb[32] = start >> 8;
    }
    __syncthreads();
}

struct MoeOrder {
    const LAS int* tb; const char* A; const char* B; size_t astep; int mode, G, c;
    __device__ __forceinline__ bool next(int i, pg8::Unit& u) const {
        const int L = i * G + c, nrt = tb[32]; if (L >= nrt * 4) return false;
        const int rt = L >> 2, pn = L & 3, bk = tb[64 + rt];
        u.pm = rt; u.pn = pn; u.A = A + (size_t)rt * astep;
        if (mode == 0) { const int g = bk / 6, pr = bk % 6, lo = pr < 3 ? 0 : (pr < 5 ? 1 : 2), hi = pr < 3 ? pr + 1 : (pr < 5 ? pr - 1 : 3);
            const int e = g * 4 + ((pn >> 1) ? hi : lo); u.B = B + ((size_t)(e * 2 + (pn & 1)) * 256) * 1024 * 2; }
        else u.B = B + ((size_t)bk * 1024 + (size_t)pn * 256) * 512 * 2;
        return true;
    }
};

#ifndef PH_MASK
#define PH_MASK 0xFFFFFF
#endif
__global__ void __launch_bounds__(512, 2) fwd_kernel(Args a) {
    extern __shared__ __attribute__((aligned(16))) unsigned char lds_raw[];
    LAS unsigned char* lds = (LAS unsigned char*)lds_raw;
    volatile LAS unsigned* MISC = (volatile LAS unsigned*)(lds + MISC_OFF);
    for (int u = threadIdx.x; u < (LDS_BYTES - MISC_OFF) / 4; u += 512) ((LAS unsigned*)(lds + MISC_OFF))[u] = 0u;
    __syncthreads();
    XcdBarrier bar = xcd_barrier_post((unsigned*)(a.ws + OFF_CTL) + CW_BAR, MISC + 8);
    LAS int* tb = (LAS int*)(lds + MISC_OFF + 1024);
#define PHASE_VARS \
    size_t z_l = 0; asm volatile("" : "+s"(z_l)); unsigned char* ws = a.ws + z_l; \
    int bx = blockIdx.x; asm volatile("" : "+s"(bx)); \
    int tid = threadIdx.x; asm volatile("" : "+v"(tid)); \
    int G = gridDim.x; asm volatile("" : "+s"(G)); \
    const int lane = tid & 63, wave = __builtin_amdgcn_readfirstlane(tid >> 6), gw = bx * 8 + wave, NGW = G * 8; \
    unsigned* ctl = (unsigned*)(ws + OFF_CTL); bf16_t* xb = (bf16_t*)(ws + OFF_XB); bf16_t* Wb = (bf16_t*)(ws + OFF_W); \
    float* cosT = (float*)(ws + OFF_COS); float* sinT = (float*)(ws + OFF_SIN); float* logf_ = (float*)(ws + OFF_LOGF); float* kbias = (float*)(ws + OFF_KBIAS); float* lse = (float*)(ws + OFF_LSE); \
    (void)lane; (void)wave; (void)gw; (void)NGW; (void)ctl; (void)xb; (void)Wb; (void)cosT; (void)sinT; (void)logf_; (void)kbias; (void)lse; (void)tid;

    { PHASE_VARS
    rows_to_bf16(a.mem, (bf16_t*)(ws + OFF_MEMB), NB * MEMLEN, gw, NGW, lane);
    for (int i = bx * 512 + tid; i < T * 32; i += G * 512) { const int tok = i >> 5, d = i & 31;
        const double inv = exp2(-(double)d * (13.287712379549449 / 32.0));
        const double rev = (double)a.positions[tok] * inv * 0.15915494309189535; const float fr = (float)(rev - floor(rev));
        cosT[i] = __builtin_amdgcn_cosf(fr); sinT[i] = __builtin_amdgcn_sinf(fr); }
    }

    for (int it = (PRE_K > 0 ? 0 : 1); it < 3; ++it) {
        const int l = it == 0 ? 0 : it - 1, cs = it, kmax = it == 0 ? PRE_K : 100;
        const float lam_init = (l == 0) ? 0.2f : 0.35550906759f;
#if (PH_MASK >> 0) & 1
        if (0 < kmax)
        { PHASE_VARS
        if (l == 0) rows_to_bf16(a.x, xb, T, gw, NGW, lane);
        convert_layer(a, l, lds, gw, NGW, wave, lane);
        for (int i = bx * 512 + tid; i < MAXRT * 256; i += G * 512) ((int*)(ws + OFF_ROWTOK))[i] = -1;
        for (int i = bx * 512 + tid; i < 20 * 1024; i += G * 512) { const int k = i >> 10, d = i & 1023;
            ((float*)(ws + OFF_RGT))[i] = k < 4 ? a.w_rg[((size_t)l * DM + d) * 4 + k] : a.w_re[(((size_t)l * 4 + ((k - 4) >> 2)) * DM + d) * 4 + ((k - 4) & 3)]; }
        xcd_barrier(bar);

        }
#endif
#if (PH_MASK >> 1) & 1
        if (1 < kmax)
        { PHASE_VARS
        { pg8::GridOrder S; S.init(xb, 1024, Wb + W_IN / 2, 1024, T, NPROJ, G, bx);
          pg8::EpiProj E{ws, cosT, sinT, a.b_forget + l * 8, logf_};
          pg8::gemm_phase(lds, pg8::Gemm{1024, 1024, 1024}, S, E); }
        { pg8::GridOrder S; S.init(ws + OFF_MEMB, 1024, Wb + W_XK / 2, 1024, NB * MEMLEN, DM, G, bx);
          pg8::EpiStore E{(bf16_t*)(ws + OFF_KX), 1024, nullptr, 1.f, 0};
          pg8::gemm_phase(lds, pg8::Gemm{1024, 1024, 1024}, S, E); }
        { pg8::GridOrder S; S.init(ws + OFF_MEMB, 1024, Wb + W_XV / 2, 1024, NB * MEMLEN, DM, G, (bx + 128) % G);
          pg8::EpiStore E{(bf16_t*)(ws + OFF_VX), 1024, nullptr, 1.f, 0};
          pg8::gemm_phase(lds, pg8::Gemm{1024, 1024, 1024}, S, E); }
        xcd_barrier(bar);

        }
#endif
#if (PH_MASK >> 2) & 1
        if (2 < kmax)
        { PHASE_VARS
        if (gw < 64) {
            const int b = gw >> 3, h = gw & 7; const float* src = logf_ + ((size_t)b * SEQ + lane * 64) * 8 + h;
            float run = 0.f;
            for (int i = 0; i < 64; ++i) run += src[(size_t)i * 8];
            float incl = run;
#pragma unroll
            for (int o = 1; o < 64; o <<= 1) { const float t = __shfl_up(incl, o); if (lane >= o) incl += t; }
            float c = incl - run; float* dst = kbias + ((size_t)b * 8 + h) * SEQ + lane * 64;
            for (int i = 0; i < 64; ++i) { c += src[(size_t)i * 8]; dst[i] = -c * LOG2E; }
        }
        for (int L = bx; L < 1536; L += G) {
            const int bs = L / 48, r = L % 48, grp = r >> 4, sub = r & 15, b = bs >> 2, slot = bs & 3;
            const int dil = grp == 0 ? 1 : (grp == 1 ? 4 : 16), nblk = 16 / dil, cls = sub / nblk, blk = sub % nblk;
            const size_t base = ((size_t)b * SEQ + cls) * 768 + grp * 256 + slot * 64;
            fa::Prm p; p.Q = (const bf16_t*)(ws + P_QC) + base; p.K = (const bf16_t*)(ws + P_KC) + base; p.V = (const bf16_t*)(ws + P_VC) + base;
            p.qld = p.kld = p.vld = 768; p.rs = dil; p.q0 = blk * 256; p.kt0 = blk * 4 - 2 < 0 ? 0 : blk * 4 - 2; p.kt1 = blk * 4 + 4; p.causal = 1; p.win = 128; p.kbias = nullptr;
            f32x16 o[2]; float m, lsum;
            fa::pass<64, 64, false>(lds, p, o, m, lsum);
            const float lt = fa::normalise<2>(lds, o, lsum);
            fa::store_o<2>(o, (bf16_t*)(ws + P_QC) + base, 768, dil, p.q0);
            if (lane < 32) { const int qi = p.q0 + wave * 32 + lane; lse[((size_t)b * SEQ + cls + (size_t)qi * dil) * 12 + grp * 4 + slot] = (m + __log2f(lt)) * LN2; }
        }
        xcd_barrier(bar);

        }
#endif
#if (PH_MASK >> 3) & 1
        if (3 < kmax)
        { PHASE_VARS
        for (int i = bx * 512 + tid; i < T * 32; i += G * 512) {
            const int tok = i >> 5, slot = (i >> 3) & 3, ch = i & 7;
            const float l0 = lse[(size_t)tok * 12 + slot], l1 = lse[(size_t)tok * 12 + 4 + slot], l2 = lse[(size_t)tok * 12 + 8 + slot];
            const float mx = fmaxf(l0, fmaxf(l1, l2)); float w0 = __expf(l0 - mx), w1 = __expf(l1 - mx), w2 = __expf(l2 - mx); const float inv = 1.f / (w0 + w1 + w2); w0 *= inv; w1 *= inv; w2 *= inv;
            const bf16_t* src = (const bf16_t*)(ws + P_QC) + (size_t)tok * 768 + slot * 64 + ch * 8;
            const u32x4 a0 = *(const u32x4*)src, a1 = *(const u32x4*)(src + 256), a2 = *(const u32x4*)(src + 512); u32x4 o;
#pragma unroll
            for (int k = 0; k < 4; ++k) {
                const float lo = w0 * __uint_as_float(a0[k] << 16) + w1 * __uint_as_float(a1[k] << 16) + w2 * __uint_as_float(a2[k] << 16);
                const float hi = w0 * __uint_as_float(a0[k] & 0xffff0000u) + w1 * __uint_as_float(a1[k] & 0xffff0000u) + w2 * __uint_as_float(a2[k] & 0xffff0000u);
                o[k] = pk2(lo, hi); }
            *(u32x4*)((bf16_t*)(ws + P_OC) + (size_t)tok * 256 + slot * 64 + ch * 8) = o;
        }
        {
            float lam;
            { const float* dl = a.diff_lambda + (size_t)l * 256; float d1 = 0.f, d2 = 0.f;
              for (int i = 0; i < 64; ++i) { d1 += dl[i] * dl[64 + i]; d2 += dl[128 + i] * dl[192 + i]; }
              lam = expf(d1) - expf(d2) + lam_init; }
            const int vcu = (G % 8 == 0) ? (bx % 8) * (G / 8) + bx / 8 : bx;
            typedef attn_body::bf16 abf;
            bf16_t* ao = (bf16_t*)(ws + P_KC) + (size_t)bx * 65536;
            const float* sg = a.diff_subln + (size_t)l * 128;
            for (int c = vcu; c < 256; c += G) {
                const int bh = c >> 3, s = c & 7, b = bh >> 2, h = bh & 3; const size_t base = (size_t)b * SEQ * 512 + h * 128;
                for (int k = 0; k < 2; ++k) { const int qb = k == 0 ? 15 - s : s;
                    for (int jv = 0; jv < 4; ++jv) { const int j = jv >> 1, vh = jv & 1;
                        attn_body::attn_unit<8, false>(qb, (const abf*)(ws + P_QA) + base + j * 64, (const abf*)(ws + P_KA) + base + j * 64, (const abf*)(ws + P_VA) + base + vh * 64,
                                                       (abf*)ao - (size_t)qb * 256 * 256 + j * 128 + vh * 64, 512, 512, 512, 256, nullptr, (char*)lds_raw); }
                    __syncthreads();
                    for (int r = 0; r < 32; ++r) { const int row = wave * 32 + r;
                        const unsigned w1 = *(const unsigned*)(ao + (size_t)row * 256 + 2 * lane), w2 = *(const unsigned*)(ao + (size_t)row * 256 + 128 + 2 * lane);
                        const float d0 = __uint_as_float(w1 << 16) - lam * __uint_as_float(w2 << 16), d1 = __uint_as_float(w1 & 0xffff0000u) - lam * __uint_as_float(w2 & 0xffff0000u);
                        const float ss = wave_sum(d0 * d0 + d1 * d1);
                        const float rn = 1.f / sqrtf(ss * (1.f / 128.f) + LN_EPS) * (1.f - lam_init);
                        *(unsigned*)((bf16_t*)(ws + P_QA) + base + (size_t)(qb * 256 + row) * 512 + 2 * lane) = pk2(d0 * rn * sg[2 * lane], d1 * rn * sg[2 * lane + 1]); }
                }
            }
            for (int c = vcu; c < 256; c += G)
                for (int e = 0; e < 2; ++e) { const int idx = 2 * c + e, bh = idx >> 3, s = idx & 7, b = bh >> 3, h = bh & 7; const size_t base = (size_t)b * SEQ * 512 + h * 64;
                    for (int k = 0; k < 2; ++k) { const int qb = k == 0 ? 15 - s : s;
                        attn_body::attn_unit<8, true>(qb, (const abf*)(ws + P_QB) + base, (const abf*)(ws + P_KB) + base, (const abf*)(ws + P_VB) + base, (abf*)(ws + P_QB) + base, 512, 512, 512, 512,
                                                      kbias + (size_t)bh * SEQ, (char*)lds_raw); } }
        }
        xcd_barrier(bar);

        }
#endif
#if (PH_MASK >> 4) & 1
        if (4 < kmax)
        { PHASE_VARS
        { pg8::GridOrder S; S.init(xb, 1024, Wb + W_GATE / 2, 1024, T, 3072, G, bx);
          pg8::EpiStore E{(bf16_t*)(ws + P_G), 3072, a.b_gate + (size_t)l * 3072, 1.f, 1};
          pg8::gemm_phase(lds, pg8::Gemm{1024, 1024, 1024}, S, E); }
        xcd_barrier(bar);

        }
#endif
#if (PH_MASK >> 5) & 1
        if (5 < kmax)
        { PHASE_VARS
        { pg8::GridOrder S; S.init(ws + P_QA, 512, Wb + W_BA / 2, 512, T, DM, G, bx);
          pg8::EpiGate E{(bf16_t*)(ws + P_G), 0}; pg8::gemm_phase(lds, pg8::Gemm{512, 512, 512}, S, E); }
        __syncthreads();
        { pg8::GridOrder S; S.init(ws + P_QB, 512, Wb + W_BB / 2, 512, T, DM, G, bx);
          pg8::EpiGate E{(bf16_t*)(ws + P_G), 1}; pg8::gemm_phase(lds, pg8::Gemm{512, 512, 512}, S, E); }
        __syncthreads();
        { pg8::GridOrder S; S.init(ws + P_OC, 256, Wb + W_BC / 2, 256, T, DM, G, bx);
          pg8::EpiGate E{(bf16_t*)(ws + P_G), 2}; pg8::gemm_phase(lds, pg8::Gemm{256, 256, 256}, S, E); }
        xcd_barrier(bar);

        }
#endif
#if (PH_MASK >> 6) & 1
        if (6 < kmax)
        { PHASE_VARS
        { pg8::GridOrder S; S.init(ws + P_G, 3072, Wb + W_OUT / 2, 1024, T, DM, G, bx);
          pg8::EpiResid E{l == 0 ? a.x : a.out, a.out, nullptr}; pg8::gemm_phase(lds, pg8::Gemm{3072, 1024, 1024}, S, E); }
        xcd_barrier(bar);
        ln_phase<false>(a, ws, l, 0, cs, gw, NGW, lane, tid, (LAS unsigned*)(lds + MISC_OFF + 256));
        xcd_barrier(bar);

        }
#endif
#if (PH_MASK >> 7) & 1
        if (7 < kmax)
        { PHASE_VARS
        { pg8::GridOrder S; S.init(xb, 1024, Wb + W_XQ / 2, 1024, T, DM, G, bx);
          pg8::EpiStore E{(bf16_t*)(ws + P_XQ), 1024, nullptr, XSCALE, 0}; pg8::gemm_phase(lds, pg8::Gemm{1024, 1024, 1024}, S, E); }
        xcd_barrier(bar);

        }
#endif
#if (PH_MASK >> 8) & 1
        if (8 < kmax)
        { PHASE_VARS
        for (int L = bx; L < 1024; L += G) {
            const int qb = L & 15, vh = (L >> 4) & 1, h = (L >> 5) & 3, b = L >> 7;
            fa::Prm p; p.Q = (const bf16_t*)(ws + P_XQ) + (size_t)b * SEQ * 1024 + h * 256; p.K = (const bf16_t*)(ws + OFF_KX) + (size_t)b * MEMLEN * 1024 + h * 256;
            p.V = (const bf16_t*)(ws + OFF_VX) + (size_t)b * MEMLEN * 1024 + h * 256 + vh * 128;
            p.qld = p.kld = p.vld = 1024; p.rs = 1; p.q0 = qb * 256; p.kt0 = 0; p.kt1 = 4; p.causal = 0; p.win = 1 << 30; p.kbias = nullptr;
            f32x16 o[4]; float m, lsum;
            fa::pass<256, 128, false, false>(lds, p, o, m, lsum);
            fa::normalise<4>(lds, o, lsum);
            fa::store_o<4>(o, (bf16_t*)(ws + P_XO) + (size_t)b * SEQ * 1024 + h * 256 + vh * 128, 1024, 1, p.q0);
        }
        xcd_barrier(bar);

        }
#endif
#if (PH_MASK >> 9) & 1
        if (9 < kmax)
        { PHASE_VARS
        { pg8::GridOrder S; S.init(ws + P_XO, 1024, Wb + W_XO / 2, 1024, T, DM, G, bx);
          pg8::EpiResid E{a.out, a.out, nullptr}; pg8::gemm_phase(lds, pg8::Gemm{1024, 1024, 1024}, S, E); }
        xcd_barrier(bar);
        ln_phase<true>(a, ws, l, 1, cs, gw, NGW, lane, tid, (LAS unsigned*)(lds + MISC_OFF + 256));
        xcd_barrier(bar);

        }
#endif
#if (PH_MASK >> 10) & 1
        if (10 < kmax)
        { PHASE_VARS
        moe_tables(a, cs, tb);
        {
            LAS unsigned* lcnt = (LAS unsigned*)(lds + MISC_OFF + 384); LAS unsigned* lbase = (LAS unsigned*)(lds + MISC_OFF + 512); LAS int* lpos = (LAS int*)(lds + MISC_OFF + 2048);
            for (int t0 = bx * 128; t0 < T; t0 += G * 128) {
                u32x4 ti = {0u, 0u, 0u, 0u}; unsigned rank = 0u;
                if (tid < 128) { ti = *(const u32x4*)(ws + OFF_TOKINFO + (size_t)(t0 + tid) * 16); rank = __hip_atomic_fetch_add(lcnt + ti.x, 1u, __ATOMIC_RELAXED, __HIP_MEMORY_SCOPE_WORKGROUP); }
                __syncthreads();
                if (tid < NBUCKET) { const unsigned c = lcnt[tid]; unsigned base = (unsigned)tb[tid];
                    if (c) base += __hip_atomic_fetch_add(ctl + CW_CUR + cs * 32 + tid, c, __ATOMIC_RELAXED, __HIP_MEMORY_SCOPE_AGENT);
                    lbase[tid] = base; }
                __syncthreads();
                if (tid < 128) { const int pos = (int)(lbase[ti.x] + rank); lpos[tid] = pos; ((int*)(ws + OFF_ROWTOK))[pos] = t0 + tid;
                    f32x2 w = {__uint_as_float(ti.y), __uint_as_float(ti.z)}; *(f32x2*)(ws + OFF_ROWW + (size_t)pos * 8) = w; }
                __syncthreads();
#pragma unroll
                for (int hh = 0; hh < 2; ++hh) { u32x4 buf[8][2];
#pragma unroll
                    for (int i = 0; i < 8; ++i) { const u32x4* src = (const u32x4*)(xb + (size_t)(t0 + wave * 16 + hh * 8 + i) * DM); buf[i][0] = src[lane]; buf[i][1] = src[64 + lane]; }
#pragma unroll
                    for (int i = 0; i < 8; ++i) { u32x4* dst = (u32x4*)((bf16_t*)(ws + P_XG) + (size_t)lpos[wave * 16 + hh * 8 + i] * DM); dst[lane] = buf[i][0]; dst[64 + lane] = buf[i][1]; } }
                __syncthreads();
                if (tid < NBUCKET) lcnt[tid] = 0u;
                __syncthreads();
            }
        }
        xcd_barrier(bar);

        }
#endif
#if (PH_MASK >> 11) & 1
        if (11 < kmax)
        { PHASE_VARS
        { MoeOrder S{tb, (const char*)(ws + P_XG), (const char*)(Wb + W_E1 / 2), (size_t)256 * 1024 * 2, 0, G, bx};
          pg8::EpiSwiglu E{(bf16_t*)(ws + P_H), (const float*)(ws + OFF_ROWW)}; pg8::gemm_phase(lds, pg8::Gemm{1024, 1024, 1024}, S, E); }
        xcd_barrier(bar);

        }
#endif
#if (PH_MASK >> 12) & 1
        if (12 < kmax)
        { PHASE_VARS
        { MoeOrder S{tb, (const char*)(ws + P_H), (const char*)(Wb + W_DP / 2), (size_t)256 * 512 * 2, 1, G, bx};
          pg8::EpiResid E{a.out, a.out, (const int*)(ws + OFF_ROWTOK)}; pg8::gemm_phase(lds, pg8::Gemm{512, 512, 512}, S, E); }
        xcd_barrier(bar);
        ln_phase<false>(a, ws, l, 2, cs, gw, NGW, lane, tid, (LAS unsigned*)(lds + MISC_OFF + 256));
        xcd_barrier(bar);
        }
#endif
    }
}

extern "C" void kernel_launch(void* const* d_in, const int* in_sizes, int n_in, void* d_out, int out_size, void* d_ws, size_t ws_size, hipStream_t stream) {
    static int grid = 0;
    if (grid == 0) {
        if (n_in != 26 || ws_size < WS_NEED) { grid = -1; return; }
        int dev = 0, cus = 0;
        if (hipGetDevice(&dev) != hipSuccess || hipDeviceGetAttribute(&cus, hipDeviceAttributeMultiprocessorCount, dev) != hipSuccess) { grid = -1; return; }
        if (hipFuncSetAttribute((const void*)fwd_kernel, hipFuncAttributeMaxDynamicSharedMemorySize, LDS_BYTES) != hipSuccess) { grid = -1; return; }
        int per_cu = 0;
        (void)hipOccupancyMaxActiveBlocksPerMultiprocessor(&per_cu, (const void*)fwd_kernel, 512, LDS_BYTES);
        (void)hipGetLastError();
        grid = cus;
    }
    if (grid < 0) return;
    (void)hipMemsetAsync((char*)d_ws + OFF_CTL, 0, CTL_BYTES, stream);
    Args a{};
    a.x = (const float*)d_in[0]; a.mem = (const float*)d_in[1]; a.positions = (const int*)d_in[2];
    a.w_in = (const float*)d_in[3]; a.b_forget = (const float*)d_in[4]; a.diff_lambda = (const float*)d_in[5]; a.diff_subln = (const float*)d_in[6];
    a.w_branch_a = (const float*)d_in[7]; a.w_branch_b = (const float*)d_in[8]; a.w_branch_c = (const float*)d_in[9]; a.w_gate = (const float*)d_in[10]; a.b_gate = (const float*)d_in[11];
    a.w_out = (const float*)d_in[12]; a.w_xq = (const float*)d_in[13]; a.w_xk = (const float*)d_in[14]; a.w_xv = (const float*)d_in[15]; a.w_xo = (const float*)d_in[16];
    a.w_rg = (const float*)d_in[17]; a.b_rg = (const float*)d_in[18]; a.w_re = (const float*)d_in[19]; a.b_re = (const float*)d_in[20];
    a.w_eg = (const float*)d_in[21]; a.w_eu = (const float*)d_in[22]; a.w_ed = (const float*)d_in[23]; a.ln_g = (const float*)d_in[24]; a.ln_b = (const float*)d_in[25];
    a.out = (float*)d_out; a.ws = (unsigned char*)d_ws;
    hipLaunchKernelGGL(fwd_kernel, dim3(grid), dim3(512), LDS_BYTES, stream, a);
}
```
